# Optimizing an MI355X kernel written in HIP

```python
import jax, jax.numpy as jnp
from jax import lax
import numpy as np

D_MODEL = 1024
BATCH = 8
SEQ = 2048
DEPTH = 2

CTX_LEN = 256
GRID_W = 64
HEAD_DIM = 64
ATTN_HEADS = 8
ATTN_KV_HEADS = 2
ATTN_GROUP = ATTN_HEADS // ATTN_KV_HEADS
WINDOW = 128
ATTN_BLOCK = 128
RET_HEADS = 8
RET_DK = 64
RET_DV = 64
RET_CHUNK = 128
FOURIER_GROUPS = 4
FOURIER_DIM = 128
ATTN_WIDTH = ATTN_HEADS * HEAD_DIM
KV_WIDTH = ATTN_KV_HEADS * HEAD_DIM
RET_QK_WIDTH = RET_HEADS * RET_DK
RET_WIDTH = RET_HEADS * RET_DV
FOURIER_WIDTH = FOURIER_GROUPS * FOURIER_DIM
N_BRANCH = 3
IN_WIDTHS = (ATTN_WIDTH, KV_WIDTH, KV_WIDTH, RET_QK_WIDTH, RET_QK_WIDTH, RET_WIDTH, RET_WIDTH, FOURIER_WIDTH, N_BRANCH * D_MODEL)
IN_COLS = sum(IN_WIDTHS)
N_GROUPS = 4
EXPERTS_PER_GROUP = 8
N_EXPERTS = N_GROUPS * EXPERTS_PER_GROUP
TOP_K = 2
EXPERT_HIDDEN = 512
MOE_BLOCK = 128
ROPE_BASE = 10000.0
NORM_EPS = 1e-6
GN_EPS = 1e-5

kernel_name = "hybrid_flow_backbone"

F32 = jnp.float32


def split_points():
    pts, acc = [], 0
    for w in IN_WIDTHS[:-1]:
        acc += w
        pts.append(acc)
    return pts


def rmsnorm(x, g):
    xf = x.astype(F32)
    y = xf * lax.rsqrt(jnp.mean(xf * xf, axis=-1, keepdims=True) + NORM_EPS)
    return (y * g.astype(F32)).astype(x.dtype)


def modulate(h, shift, scale):
    return h * (1.0 + scale) + shift


def rope_table(pos, n_freq):
    inv = ROPE_BASE ** (-jnp.arange(n_freq, dtype=F32) / n_freq)
    ang = pos[:, None] * inv[None, :]
    return jnp.cos(ang), jnp.sin(ang)


def rotate(x, cos, sin):
    f = x.shape[-1] // 2
    x1, x2 = x[..., :f], x[..., f:]
    c = cos[None, :, None, :].astype(x.dtype)
    s = sin[None, :, None, :].astype(x.dtype)
    return jnp.concatenate([x1 * c - x2 * s, x1 * s + x2 * c], axis=-1)


def axial_rope(x, row_cs, col_cs):
    h = x.shape[-1] // 2
    return jnp.concatenate([rotate(x[..., :h], *row_cs), rotate(x[..., h:], *col_cs)], axis=-1)


def window_attention(q, k, v, kc, vc, sink):
    B, N, H, Dh = q.shape
    L = kc.shape[1]
    nb = N // ATTN_BLOCK
    nw = 3 * ATTN_BLOCK
    scale = Dh ** -0.5
    qb = q.reshape(B, nb, ATTN_BLOCK, ATTN_KV_HEADS, ATTN_GROUP, Dh)

    def windows(t):
        tp = jnp.pad(t, ((0, 0), (ATTN_BLOCK, ATTN_BLOCK), (0, 0), (0, 0)))
        tb = tp.reshape(B, nb + 2, ATTN_BLOCK, ATTN_KV_HEADS, Dh)
        return jnp.concatenate([tb[:, :-2], tb[:, 1:-1], tb[:, 2:]], axis=2)

    kw, vw = windows(k), windows(v)
    kpos = jnp.arange(-ATTN_BLOCK, N + ATTN_BLOCK).reshape(nb + 2, ATTN_BLOCK)
    kpos = jnp.concatenate([kpos[:-2], kpos[1:-1], kpos[2:]], axis=1)
    qpos = jnp.arange(N).reshape(nb, ATTN_BLOCK)
    kp = kpos[:, None, :]
    valid = (jnp.abs(qpos[:, :, None] - kp) <= WINDOW) & (kp >= 0) & (kp < N)
    s_loc = jnp.einsum('bnqhgd,bnkhd->bnhgqk', qb, kw).astype(F32) * scale
    s_loc = jnp.where(valid[None, :, None, None], s_loc, -jnp.inf)
    s_ctx = jnp.einsum('bnqhgd,blhd->bnhgql', qb, kc).astype(F32) * scale
    s_snk = jnp.broadcast_to(sink.astype(F32).reshape(1, 1, ATTN_KV_HEADS, ATTN_GROUP, 1, 1), s_loc.shape[:-1] + (1,))
    p = jax.nn.softmax(jnp.concatenate([s_loc, s_ctx, s_snk], axis=-1), axis=-1).astype(v.dtype)
    o = (jnp.einsum('bnhgqk,bnkhd->bnqhgd', p[..., :nw], vw)
         + jnp.einsum('bnhgql,blhd->bnqhgd', p[..., nw:nw + L], vc))
    return o.reshape(B, N, H * Dh)


def context_attention(q, k, v, sink):
    B, L, H, Dh = q.shape
    qg = q.reshape(B, L, ATTN_KV_HEADS, ATTN_GROUP, Dh)
    s = jnp.einsum('bqhgd,bkhd->bhgqk', qg, k).astype(F32) * (Dh ** -0.5)
    s_snk = jnp.broadcast_to(sink.astype(F32).reshape(1, ATTN_KV_HEADS, ATTN_GROUP, 1, 1), s.shape[:-1] + (1,))
    p = jax.nn.softmax(jnp.concatenate([s, s_snk], axis=-1), axis=-1)[..., :L].astype(v.dtype)
    o = jnp.einsum('bhgqk,bkhd->bqhgd', p, v)
    return o.reshape(B, L, H * Dh)


def fourier_mix(u):
    B, N, _ = u.shape
    ug = u.astype(F32).reshape(B, N, FOURIER_GROUPS, FOURIER_DIM)
    z = jnp.fft.fft2(ug, axes=(1, 3), norm='ortho')
    return jnp.real(z).reshape(B, N, FOURIER_WIDTH).astype(u.dtype)


def retention_chunked(q, k, v, lg, s0, inclusive):
    B, N, H, dk = q.shape
    dv = v.shape[-1]
    nc = N // RET_CHUNK
    qc = q.astype(F32).reshape(B, nc, RET_CHUNK, H, dk)
    kc = k.astype(F32).reshape(B, nc, RET_CHUNK, H, dk)
    vc = v.astype(F32).reshape(B, nc, RET_CHUNK, H, dv)
    i = jnp.arange(RET_CHUNK)
    diff = i[:, None] - i[None, :]
    mask = (diff >= 0) if inclusive else (diff > 0)
    dec = jnp.where(mask[None], jnp.exp(jnp.where(mask, diff, 0).astype(F32)[None] * lg[:, None, None]), 0.0)
    inner = jnp.einsum('bcihd,bcjhd->bchij', qc, kc) * dec[None, None]
    o_inner = jnp.einsum('bchij,bcjhe->bcihe', inner, vc)
    fi = i.astype(F32)
    zeta = jnp.exp((RET_CHUNK - 1 - fi)[:, None] * lg[None, :])
    u = jnp.einsum('bcjhd,jh,bcjhe->bchde', kc, zeta, vc)
    g_chunk = jnp.exp(RET_CHUNK * lg)[None, :, None, None]

    def step(s, u_c):
        return g_chunk * s + u_c, s

    _, s_prev = lax.scan(step, s0.astype(F32), jnp.moveaxis(u, 1, 0))
    s_prev = jnp.moveaxis(s_prev, 0, 1)
    xi = jnp.exp((fi + 1.0)[:, None] * lg[None, :])
    o_cross = jnp.einsum('bcihd,ih,bchde->bcihe', qc, xi, s_prev)
    return (o_inner + o_cross).reshape(B, N, H, dv)


def context_states(k, v, lg_f, lg_b):
    L = k.shape[1]
    m = jnp.arange(L, dtype=F32)
    w_f = jnp.exp((L - 1 - m)[:, None] * lg_f[None, :])
    w_b = jnp.exp(m[:, None] * lg_b[None, :])
    kf, vf = k.astype(F32), v.astype(F32)
    s_f = jnp.einsum('blhd,lh,blhe->bhde', kf, w_f, vf)
    s_b = jnp.einsum('blhd,lh,blhe->bhde', kf, w_b, vf)
    return s_f, s_b


def bidir_retention(q, k, v, lg_f, lg_b, s_f, s_b):
    flip = lambda t: jnp.flip(t, axis=1)
    o_f = retention_chunked(q, k, v, lg_f, s_f, True)
    o_b = flip(retention_chunked(flip(q), flip(k), flip(v), lg_b, s_b, False))
    return o_f + o_b


def retention_out(o, g):
    B, T = o.shape[0], o.shape[1]
    mu = jnp.mean(o, axis=-1, keepdims=True)
    var = jnp.mean(jnp.square(o - mu), axis=-1, keepdims=True)
    on = ((o - mu) * lax.rsqrt(var + GN_EPS)).reshape(B, T, RET_WIDTH)
    return (jax.nn.silu(g.astype(F32)) * on).astype(g.dtype)


def token_mixer(hc, hl, w_in, sink, dec_f, dec_b, w_ba, w_bf, w_br, w_out, row_cs, col_cs, ret_cs, need_ctx):
    B, L, _ = hc.shape
    h = jnp.concatenate([hc, hl], axis=1)
    T = h.shape[1]
    proj = h @ w_in
    qa, ka, va, qr, kr, vr, gr, fu, gates = jnp.split(proj, split_points(), axis=-1)
    qa = qa.reshape(B, T, ATTN_HEADS, HEAD_DIM)
    ka = ka.reshape(B, T, ATTN_KV_HEADS, HEAD_DIM)
    va = va.reshape(B, T, ATTN_KV_HEADS, HEAD_DIM)
    qr = qr.reshape(B, T, RET_HEADS, RET_DK)
    kr = kr.reshape(B, T, RET_HEADS, RET_DK) * (RET_DK ** -0.5)
    vr = vr.reshape(B, T, RET_HEADS, RET_DV)
    oa_l = window_attention(axial_rope(qa[:, L:], row_cs, col_cs), axial_rope(ka[:, L:], row_cs, col_cs),
                            va[:, L:], ka[:, :L], va[:, :L], sink)
    of_l = fourier_mix(fu[:, L:])
    lg_f = jax.nn.log_sigmoid(dec_f.astype(F32))
    lg_b = jax.nn.log_sigmoid(dec_b.astype(F32))
    s_f, s_b = context_states(kr[:, :L], vr[:, :L], lg_f, lg_b)
    or_l = bidir_retention(rotate(qr[:, L:], *ret_cs), rotate(kr[:, L:], *ret_cs), vr[:, L:], lg_f, lg_b, s_f, s_b)
    if need_ctx:
        zero = jnp.zeros_like(s_f)
        oa = jnp.concatenate([context_attention(qa[:, :L], ka[:, :L], va[:, :L], sink), oa_l], axis=1)
        of = jnp.concatenate([fourier_mix(fu[:, :L]), of_l], axis=1)
        orr = jnp.concatenate([bidir_retention(qr[:, :L], kr[:, :L], vr[:, :L], lg_f, lg_b, zero, zero), or_l], axis=1)
        g_r, g_m = gr, gates
    else:
        oa, of, orr = oa_l, of_l, or_l
        g_r, g_m = gr[:, L:], gates[:, L:]
    ret = retention_out(orr, g_r)
    ga, gf, gt = jnp.split(jax.nn.sigmoid(g_m), 3, axis=-1)
    y = (ga * (oa @ w_ba) + gf * (of @ w_bf) + gt * (ret @ w_br)) @ w_out
    if need_ctx:
        return y[:, :L], y[:, L:]
    return None, y


def expert_ffn(xb, e, w_g, w_u, w_d):
    return (jax.nn.silu(xb @ w_g[e]) * (xb @ w_u[e])) @ w_d[e]


def hier_moe(h, w_rg, b_rg, w_re, b_re, w_g, w_u, w_d):
    T, D = h.shape
    hf = h.astype(F32)
    lg_grp = hf @ w_rg.astype(F32) + b_rg.astype(F32)
    p_grp = jax.nn.softmax(lg_grp, axis=-1)
    grp = jnp.argmax(lg_grp, axis=-1)
    pg = jnp.take_along_axis(p_grp, grp[:, None], axis=1)
    lg_e = (hf @ w_re.astype(F32) + b_re.astype(F32)).reshape(T, N_GROUPS, EXPERTS_PER_GROUP)
    lg_in = jnp.take_along_axis(lg_e, grp[:, None, None], axis=1)[:, 0]
    top_v, top_i = lax.top_k(lg_in, TOP_K)
    w = pg * jax.nn.softmax(top_v, axis=-1)
    flat_e = (grp[:, None] * EXPERTS_PER_GROUP + top_i).reshape(-1).astype(jnp.int32)
    flat_w = w.reshape(-1)
    A = T * TOP_K
    flat_tok = jnp.repeat(jnp.arange(T, dtype=jnp.int32), TOP_K)
    order = jnp.argsort(flat_e)
    se, st, sw = flat_e[order], flat_tok[order], flat_w[order]
    counts = jnp.zeros((N_EXPERTS,), jnp.int32).at[flat_e].add(1)
    pcounts = (counts + MOE_BLOCK - 1) // MOE_BLOCK * MOE_BLOCK
    start = jnp.cumsum(counts) - counts
    pend = jnp.cumsum(pcounts)
    pstart = pend - pcounts
    dest = pstart[se] + jnp.arange(A, dtype=jnp.int32) - start[se]
    n_blocks = -(-A // MOE_BLOCK) + N_EXPERTS
    P = n_blocks * MOE_BLOCK
    buf_tok = jnp.full((P,), T, jnp.int32).at[dest].set(st)
    buf_w = jnp.zeros((P,), F32).at[dest].set(sw)
    blk_e = jnp.minimum(jnp.searchsorted(pend, jnp.arange(n_blocks, dtype=jnp.int32) * MOE_BLOCK, side='right'), N_EXPERTS - 1)
    h_pad = jnp.concatenate([h, jnp.zeros((1, D), h.dtype)], axis=0)
    xb = h_pad[buf_tok].reshape(n_blocks, MOE_BLOCK, D)
    y = lax.map(lambda a: expert_ffn(a[0], a[1], w_g, w_u, w_d), (xb, blk_e))
    out = jnp.zeros((T + 1, D), F32).at[buf_tok].add(y.reshape(P, D).astype(F32) * buf_w[:, None])
    return out[:T].astype(h.dtype)


def setup_inputs(seed: int = 0) -> dict:
    key = jax.random.key(seed)
    ks = jax.random.split(key, 24)
    D = D_MODEL
    nrm = lambda k, shape, s: jax.random.normal(k, shape, F32) * s
    base_logit = jnp.asarray(np.log(2.0 ** (5 + np.arange(RET_HEADS)) - 1.0).astype(np.float32))
    return {
        'x': nrm(ks[0], (BATCH, SEQ, D), 1.0),
        'c': nrm(ks[1], (BATCH, D), 1.0),
        'ctx': nrm(ks[2], (BATCH, CTX_LEN, D), 1.0),
        'c_ctx': nrm(ks[3], (D,), 1.0),
        'norm_mix': 1.0 + nrm(ks[4], (DEPTH, D), 0.05),
        'norm_ffn': 1.0 + nrm(ks[5], (DEPTH, D), 0.05),
        'w_ada': nrm(ks[6], (DEPTH, D, 6 * D), 0.5 * D ** -0.5),
        'b_ada': nrm(ks[7], (DEPTH, 6 * D), 0.02),
        'w_in': nrm(ks[8], (DEPTH, D, IN_COLS), D ** -0.5),
        'attn_sink': nrm(ks[9], (DEPTH, ATTN_HEADS), 0.5),
        'ret_decay_fwd': base_logit[None, :] + nrm(ks[10], (DEPTH, RET_HEADS), 0.1),
        'ret_decay_bwd': base_logit[None, :] + nrm(ks[11], (DEPTH, RET_HEADS), 0.1),
        'w_branch_attn': nrm(ks[12], (DEPTH, ATTN_WIDTH, D), ATTN_WIDTH ** -0.5),
        'w_branch_fourier': nrm(ks[13], (DEPTH, FOURIER_WIDTH, D), FOURIER_WIDTH ** -0.5),
        'w_branch_ret': nrm(ks[14], (DEPTH, RET_WIDTH, D), RET_WIDTH ** -0.5),
        'w_out': nrm(ks[15], (DEPTH, D, D), D ** -0.5),
        'w_router_group': nrm(ks[16], (DEPTH, D, N_GROUPS), D ** -0.5),
        'b_router_group': nrm(ks[17], (DEPTH, N_GROUPS), 0.01),
        'w_router_expert': nrm(ks[18], (DEPTH, D, N_EXPERTS), D ** -0.5),
        'b_router_expert': nrm(ks[19], (DEPTH, N_EXPERTS), 0.01),
        'w_exp_gate': nrm(ks[20], (DEPTH, N_EXPERTS, D, EXPERT_HIDDEN), D ** -0.5),
        'w_exp_up': nrm(ks[21], (DEPTH, N_EXPERTS, D, EXPERT_HIDDEN), D ** -0.5),
        'w_exp_down': nrm(ks[22], (DEPTH, N_EXPERTS, EXPERT_HIDDEN, D), EXPERT_HIDDEN ** -0.5),
        'norm_final': 1.0 + nrm(ks[23], (D,), 0.05),
    }


def reference(x, c, ctx, c_ctx, norm_mix, norm_ffn, w_ada, b_ada, w_in, attn_sink, ret_decay_fwd, ret_decay_bwd,
              w_branch_attn, w_branch_fourier, w_branch_ret, w_out, w_router_group, b_router_group,
              w_router_expert, b_router_expert, w_exp_gate, w_exp_up, w_exp_down, norm_final):
    B, N, D = x.shape
    L = ctx.shape[1]
    ROWS = N // GRID_W
    row = jnp.repeat(jnp.arange(ROWS, dtype=F32), GRID_W)
    col = jnp.tile(jnp.arange(GRID_W, dtype=F32), ROWS)
    row_cs = rope_table(row, HEAD_DIM // 4)
    col_cs = rope_table(col, HEAD_DIM // 4)
    ret_cs = rope_table(jnp.arange(N, dtype=F32), RET_DK // 2)
    xc, xl = ctx, x
    for l in range(DEPTH):
        need_ctx = l < DEPTH - 1
        mod_l = (jax.nn.silu(c) @ w_ada[l] + b_ada[l])[:, None, :]
        mod_c = (jax.nn.silu(c_ctx) @ w_ada[l] + b_ada[l])[None, None, :]
        sh1_l, sc1_l, g1_l, sh2_l, sc2_l, g2_l = jnp.split(mod_l, 6, axis=-1)
        sh1_c, sc1_c, g1_c, sh2_c, sc2_c, g2_c = jnp.split(mod_c, 6, axis=-1)
        hl = modulate(rmsnorm(xl, norm_mix[l]), sh1_l, sc1_l)
        hc = modulate(rmsnorm(xc, norm_mix[l]), sh1_c, sc1_c)
        yc, yl = token_mixer(hc, hl, w_in[l], attn_sink[l], ret_decay_fwd[l], ret_decay_bwd[l],
                             w_branch_attn[l], w_branch_fourier[l], w_branch_ret[l], w_out[l],
                             row_cs, col_cs, ret_cs, need_ctx)
        xl = xl + g1_l * yl
        hl2 = modulate(rmsnorm(xl, norm_ffn[l]), sh2_l, sc2_l)
        moe_args = (w_router_group[l], b_router_group[l], w_router_expert[l], b_router_expert[l],
                    w_exp_gate[l], w_exp_up[l], w_exp_down[l])
        if need_ctx:
            xc = xc + g1_c * yc
            hc2 = modulate(rmsnorm(xc, norm_ffn[l]), sh2_c, sc2_c)
            h2 = jnp.concatenate([hc2, hl2], axis=1)
            f = hier_moe(h2.reshape(-1, D), *moe_args).reshape(B, L + N, D)
            xc = xc + g2_c * f[:, :L]
            xl = xl + g2_l * f[:, L:]
        else:
            f = hier_moe(hl2.reshape(-1, D), *moe_args).reshape(B, N, D)
            xl = xl + g2_l * f
    return rmsnorm(xl, norm_final)
```

```cpp
#include <hip/hip_runtime.h>
#define MK_LAUNCHES 1
#include <hip/hip_cooperative_groups.h>
#include <cstdio>
#include <cstdint>
namespace cg = cooperative_groups;

#define DI __device__ __forceinline__
#define LAS __attribute__((address_space(3)))
typedef unsigned short bf16_t;
typedef short bf16x8 __attribute__((ext_vector_type(8)));
typedef short s16x4 __attribute__((ext_vector_type(4)));
typedef float f32x2 __attribute__((ext_vector_type(2)));
typedef float f32x4 __attribute__((ext_vector_type(4)));
typedef float f32x16 __attribute__((ext_vector_type(16)));
typedef unsigned u32x2 __attribute__((ext_vector_type(2)));
typedef unsigned u32x4 __attribute__((ext_vector_type(4)));
typedef __bf16 bf16x2_t __attribute__((ext_vector_type(2)));

DI unsigned pk2(float lo, float hi) { f32x2 v = {lo, hi}; bf16x2_t b = __builtin_convertvector(v, bf16x2_t); return __builtin_bit_cast(unsigned, b); }
DI float bflo(unsigned u) { return __uint_as_float(u << 16); }
DI float bfhi(unsigned u) { return __uint_as_float(u & 0xffff0000u); }
DI float bf2f(bf16_t b) { return __uint_as_float((unsigned)b << 16); }
DI bf16_t f2bf(float f) { return (bf16_t)(pk2(f, 0.f) & 0xffffu); }
DI float fast_exp2(float x) { return __builtin_amdgcn_exp2f(x); }
DI float sigmoidf_(float x) { return __builtin_amdgcn_rcpf(1.0f + __expf(-x)); }
DI float siluf_(float x) { return x * __builtin_amdgcn_rcpf(1.0f + __expf(-x)); }
DI const float* opaque_ptr(const float* p) { asm volatile("" : "+s"(p)); return p; }
DI float shx(float v, int m, int lane) { return __int_as_float(__builtin_amdgcn_ds_bpermute((lane ^ m) << 2, __float_as_int(v))); }
DI float wave_sum(float v, int lane) {
#pragma unroll
    for (int o = 1; o < 64; o <<= 1) v += shx(v, o, lane);
    return v;
}
DI void sincos_d(double x, double& s, double& c) {
    const double inv = 0.63661977236758134308;
    const double q = __builtin_rint(x * inv);
    const double p1 = 1.57079632673412561417e+00, p2 = 6.07710050650619224932e-11, p3 = 2.02226624879595063154e-21;
    double r = x - q * p1; r -= q * p2; r -= q * p3;
    const double r2 = r * r;
    double sp = -1.0 / 121645100408832000.0;
    sp = sp * r2 + 1.0 / 355687428096000.0;
    sp = sp * r2 - 1.0 / 1307674368000.0;
    sp = sp * r2 + 1.0 / 6227020800.0;
    sp = sp * r2 - 1.0 / 39916800.0;
    sp = sp * r2 + 1.0 / 362880.0;
    sp = sp * r2 - 1.0 / 5040.0;
    sp = sp * r2 + 1.0 / 120.0;
    sp = sp * r2 - 1.0 / 6.0;
    const double sr = r + r * r2 * sp;
    double cp = 1.0 / 6402373705728000.0;
    cp = cp * r2 - 1.0 / 20922789888000.0;
    cp = cp * r2 + 1.0 / 87178291200.0;
    cp = cp * r2 - 1.0 / 479001600.0;
    cp = cp * r2 + 1.0 / 3628800.0;
    cp = cp * r2 - 1.0 / 40320.0;
    cp = cp * r2 + 1.0 / 720.0;
    cp = cp * r2 - 1.0 / 24.0;
    cp = cp * r2 + 0.5;
    const double cr = 1.0 - r2 * cp;
    const int qi = (int)q & 3;
    s = (qi == 0) ? sr : (qi == 1) ? cr : (qi == 2) ? -sr : -cr;
    c = (qi == 0) ? cr : (qi == 1) ? -sr : (qi == 2) ? -cr : sr;
}

namespace pg8 {
constexpr int BM = 256, BK = 64, HALF = 128, HTB = HALF * BK * 2, STAGE_BYTES = 8 * HTB;
DI int lds_byte(int r, int c) { const int st = (r >> 4) * 2 + (c >> 5), rr = r & 15, cc = c & 31, ob = rr * 64 + cc * 2; return st * 1024 + (ob ^ (((ob >> 9) & 1) << 5)); }
DI void stage_rc(int b, int& R, int& C) { const int st = b / 1024, sb = b % 1024, swz = sb ^ (((sb >> 9) & 1) << 5); R = (st >> 1) * 16 + swz / 64; C = (st & 1) * 32 + (swz % 64) / 2; }
DI int perm32(int rho) { const int n = rho >> 4, i = rho & 15; return 8 * (i >> 2) + 4 * n + (i & 3); }

struct Unit { const char* a; const char* b; void* o0; const void* o1; const void* o2; int ld; int rows; int flag; const int* gidx; };

template <class Epi, class Sched, bool ALIGN_EPI, bool SP2, bool GATHER = false>
DI void gemm_phase(LAS unsigned char* lds, const int K, const Sched& S, const Epi& E, const int tid, const int lda = 0, const int ldb = 0) {
    const int LA = lda ? lda : K, LB = ldb ? ldb : K;
    const int  wid = __builtin_amdgcn_readfirstlane(tid >> 6), lane = tid & 63, wr = wid >> 2, wc = wid & 3, fr = lane & 15, fq = lane >> 4;
    const int nt = K / BK;
    unsigned voffA[2], voffB[2];
#pragma unroll
    for (int i = 0; i < 2; ++i) { int R, C; stage_rc(tid * 16 + i * 8192, R, C); const int Rb = Epi::PERM ? ((R & ~31) + perm32(R & 31)) : R;
        voffA[i] = (unsigned)(R * LA + C) * 2u; voffB[i] = (unsigned)(Rb * LB + C) * 2u; }
    const size_t kstep = (size_t)(BK * 2);
    const size_t hstepA = (size_t)HALF * LA * 2, hstepB = (size_t)HALF * LB * 2;
    const unsigned ldsw = (unsigned)wid * 1024u;
    const int aoff = lds_byte(wr * 64 + fr, fq * 8), boff = lds_byte(wc * 32 + fr, fq * 8);
#define PG8_SA(b, h) (((b) * 2 + (h)) * HTB)
#define PG8_SB(b, h) ((4 + (b) * 2 + (h)) * HTB)
#define PG8_STAGE(bufoff, gbase, voff) do { _Pragma("unroll") for (int _i = 0; _i < 2; ++_i) \
        __builtin_amdgcn_global_load_lds((const unsigned*)((const char*)(gbase) + (voff)[_i]), (LAS unsigned*)(lds + (bufoff) + ldsw + _i * 8192), 16, 0, 0); } while (0)
#define PG8_STAGE_A(bufoff, gbase, half, nextu) do { if constexpr (GATHER) { _Pragma("unroll") for (int _i = 0; _i < 2; ++_i) { const unsigned _o = (nextu) ? gnx[half][_i] : gof[half][_i]; \
        __builtin_amdgcn_global_load_lds((const unsigned*)((const char*)(gbase) + _o), (LAS unsigned*)(lds + (bufoff) + ldsw + _i * 8192), 16, 0, 0); } } \
        else { PG8_STAGE(bufoff, (gbase) + ((half) ? hstepA : 0), voffA); } } while (0)
#define PG8_LDA(dst, b, h) do { _Pragma("unroll") for (int m = 0; m < 4; ++m) _Pragma("unroll") for (int k = 0; k < 2; ++k) dst[m][k] = *(const LAS bf16x8*)(lds + PG8_SA(b, h) + aoff + m * 2048 + k * 1024); } while (0)
#define PG8_LDB(dst, b, h) do { _Pragma("unroll") for (int n = 0; n < 2; ++n) _Pragma("unroll") for (int k = 0; k < 2; ++k) dst[n][k] = *(const LAS bf16x8*)(lds + PG8_SB(b, h) + boff + n * 2048 + k * 1024); } while (0)
#define PG8_MMA(ai, bj, At, Bt) do { __builtin_amdgcn_s_setprio(1); _Pragma("unroll") for (int m = 0; m < 4; ++m) _Pragma("unroll") for (int n = 0; n < 2; ++n) _Pragma("unroll") for (int k = 0; k < 2; ++k) \
        acc[ai][bj][m][n] = __builtin_amdgcn_mfma_f32_16x16x32_bf16(Bt[n][k], At[m][k], acc[ai][bj][m][n], 0, 0, 0); __builtin_amdgcn_s_setprio(0); } while (0)
#define PG8_WAIT_V(n) asm volatile("s_waitcnt vmcnt(" #n ")" ::: "memory")
#define PG8_WAIT_L(n) asm volatile("s_waitcnt lgkmcnt(" #n ")" ::: "memory")
#define PG8_BAR __builtin_amdgcn_s_barrier()
#define PG8_SCHED __builtin_amdgcn_sched_barrier(0)
    Unit cur, nxt; int ui = 0;
    if (!S.next(0, cur)) return;
    unsigned gof[2][2], gnx[2][2];
    if constexpr (GATHER) {
#pragma unroll
        for (int hh = 0; hh < 2; ++hh)
#pragma unroll
            for (int i = 0; i < 2; ++i) { int gR, gC; stage_rc(tid * 16 + i * 8192, gR, gC); const int r = hh * HALF + gR; const int row = (r < cur.rows) ? (cur.gidx[r] >> 1) : 0; gof[hh][i] = (unsigned)(row * LA + gC) * 2u; gnx[hh][i] = gof[hh][i]; }
    }
    f32x4 acc[2][2][4][2];
#pragma unroll
    for (int a = 0; a < 2; ++a)
#pragma unroll
        for (int b = 0; b < 2; ++b)
#pragma unroll
            for (int m = 0; m < 4; ++m)
#pragma unroll
                for (int n = 0; n < 2; ++n) acc[a][b][m][n] = (f32x4){0.f, 0.f, 0.f, 0.f};
    bf16x8 At[4][2], B0[2][2], B1[2][2];
    const char* cA = cur.a; const char* cB = cur.b;
    if constexpr (SP2) {
        PG8_STAGE(PG8_SB(0, 0), cB, voffB); PG8_STAGE(PG8_SB(0, 1), cB + hstepB, voffB); PG8_STAGE_A(PG8_SA(0, 0), cA, 0, false); PG8_STAGE_A(PG8_SA(0, 1), cA, 1, false);
        if (wr == 1) PG8_BAR;
        PG8_WAIT_V(2); PG8_BAR;
        PG8_STAGE(PG8_SB(1, 0), cB + kstep, voffB); PG8_STAGE_A(PG8_SA(1, 0), cA + kstep, 0, false); PG8_STAGE(PG8_SB(1, 1), cB + hstepB + kstep, voffB);
        PG8_WAIT_V(6); PG8_BAR;
    } else {
        PG8_STAGE(PG8_SB(0, 0), cB, voffB); PG8_STAGE_A(PG8_SA(0, 0), cA, 0, false); PG8_STAGE(PG8_SB(0, 1), cB + hstepB, voffB); PG8_STAGE_A(PG8_SA(0, 1), cA, 1, false);
        if (wr == 1) PG8_BAR;
        PG8_WAIT_V(4); PG8_BAR;
        PG8_STAGE(PG8_SB(1, 0), cB + kstep, voffB); PG8_STAGE_A(PG8_SA(1, 0), cA + kstep, 0, false); PG8_STAGE(PG8_SB(1, 1), cB + hstepB + kstep, voffB);
        PG8_WAIT_V(6); PG8_BAR;
    }
    for (;;) {
        const bool has_next = S.next(ui + 1, nxt);
        if constexpr (GATHER) { if (has_next) {
#pragma unroll
            for (int hh = 0; hh < 2; ++hh)
#pragma unroll
                for (int i = 0; i < 2; ++i) { int t2 = tid; asm volatile("" : "+v"(t2)); int gR, gC; stage_rc(t2 * 16 + i * 8192, gR, gC); const int r = hh * HALF + gR; const int row = (r < nxt.rows) ? (nxt.gidx[r] >> 1) : 0; gnx[hh][i] = (unsigned)(row * LA + gC) * 2u; } } }
        const char* nA = has_next ? nxt.a : cA; const char* nB = has_next ? nxt.b : cB;
        for (int t = 0; t < nt; t += 2) {
            const bool last = (t == nt - 2);
            const char* a1 = cA + (size_t)(t + 1) * kstep;
            const char* a2 = last ? nA : cA + (size_t)(t + 2) * kstep; const char* b2 = last ? nB : cB + (size_t)(t + 2) * kstep;
            const char* a3 = a2 + kstep; const char* b3 = b2 + kstep;
            if constexpr (SP2) {
            PG8_LDB(B0, 0, 0); PG8_LDB(B1, 0, 1); PG8_SCHED; PG8_LDA(At, 0, 0); PG8_STAGE_A(PG8_SA(1, 1), a1, 1, false);
            PG8_WAIT_V(8); PG8_WAIT_L(0); PG8_BAR; PG8_MMA(0, 0, At, B0); PG8_MMA(0, 1, At, B1); PG8_BAR; PG8_SCHED;
            PG8_LDA(At, 0, 1); PG8_STAGE(PG8_SB(0, 0), b2, voffB); PG8_STAGE(PG8_SB(0, 1), b2 + hstepB, voffB); PG8_STAGE_A(PG8_SA(0, 0), a2, 0, last);
            PG8_WAIT_V(8); PG8_WAIT_L(0); PG8_BAR; PG8_MMA(1, 0, At, B0); PG8_MMA(1, 1, At, B1); PG8_BAR; PG8_SCHED;
            PG8_LDB(B0, 1, 0); PG8_LDB(B1, 1, 1); PG8_SCHED; PG8_LDA(At, 1, 0); PG8_STAGE_A(PG8_SA(0, 1), a2, 1, last);
            PG8_WAIT_V(8); PG8_WAIT_L(0); PG8_BAR; PG8_MMA(0, 0, At, B0); PG8_MMA(0, 1, At, B1); PG8_BAR; PG8_SCHED;
            PG8_LDA(At, 1, 1); PG8_STAGE(PG8_SB(1, 0), b3, voffB); PG8_STAGE(PG8_SB(1, 1), b3 + hstepB, voffB); PG8_STAGE_A(PG8_SA(1, 0), a3, 0, last);
            PG8_WAIT_V(8); PG8_WAIT_L(0); PG8_BAR; PG8_MMA(1, 0, At, B0); PG8_MMA(1, 1, At, B1); PG8_BAR; PG8_SCHED;
            } else {
            PG8_LDB(B0, 0, 0); PG8_SCHED; PG8_LDA(At, 0, 0); PG8_STAGE_A(PG8_SA(1, 1), a1, 1, false);
            PG8_WAIT_L(8); PG8_BAR; PG8_WAIT_L(0); PG8_MMA(0, 0, At, B0); PG8_BAR; PG8_SCHED;
            PG8_LDB(B1, 0, 1); PG8_STAGE(PG8_SB(0, 0), b2, voffB);
            PG8_BAR; PG8_WAIT_L(0); PG8_MMA(0, 1, At, B1); PG8_BAR;
            PG8_LDA(At, 0, 1); PG8_STAGE_A(PG8_SA(0, 0), a2, 0, last);
            PG8_BAR; PG8_WAIT_L(0); PG8_MMA(1, 0, At, B0); PG8_BAR; PG8_SCHED;
            PG8_STAGE(PG8_SB(0, 1), b2 + hstepB, voffB);
            PG8_WAIT_V(6); PG8_BAR; PG8_MMA(1, 1, At, B1); PG8_BAR;
            PG8_LDB(B0, 1, 0); PG8_SCHED; PG8_LDA(At, 1, 0); PG8_STAGE_A(PG8_SA(0, 1), a2, 1, last);
            PG8_WAIT_L(8); PG8_BAR; PG8_WAIT_L(0); PG8_MMA(0, 0, At, B0); PG8_BAR; PG8_SCHED;
            PG8_LDB(B1, 1, 1); PG8_STAGE(PG8_SB(1, 0), b3, voffB);
            PG8_BAR; PG8_WAIT_L(0); PG8_MMA(0, 1, At, B1); PG8_BAR;
            PG8_LDA(At, 1, 1); PG8_STAGE_A(PG8_SA(1, 0), a3, 0, last);
            PG8_BAR; PG8_WAIT_L(0); PG8_MMA(1, 0, At, B0); PG8_BAR; PG8_SCHED;
            PG8_STAGE(PG8_SB(1, 1), b3 + hstepB, voffB);
            PG8_WAIT_V(6); PG8_BAR; PG8_MMA(1, 1, At, B1); PG8_BAR;
            }
        }
        if constexpr (ALIGN_EPI) { if (wr == 0) PG8_BAR; }
        const bool keep = E(acc, cur, wr, wc, fr, fq);
        if (!has_next) break;
        if (!keep) {
#pragma unroll
        for (int a = 0; a < 2; ++a)
#pragma unroll
            for (int b = 0; b < 2; ++b)
#pragma unroll
                for (int m = 0; m < 4; ++m)
#pragma unroll
                    for (int n = 0; n < 2; ++n) acc[a][b][m][n] = (f32x4){0.f, 0.f, 0.f, 0.f};
        }
        if constexpr (GATHER) {
#pragma unroll
            for (int hh = 0; hh < 2; ++hh)
#pragma unroll
                for (int i = 0; i < 2; ++i) gof[hh][i] = gnx[hh][i]; }
        cur = nxt; cA = nA; cB = nB; ++ui;
        if constexpr (ALIGN_EPI) { if (wr == 1) PG8_BAR; }
    }
    PG8_WAIT_V(0);
    if constexpr (!ALIGN_EPI) { if (wr == 0) PG8_BAR; }
    PG8_BAR;
#undef PG8_SA
#undef PG8_SB
#undef PG8_STAGE
#undef PG8_STAGE_A
#undef PG8_LDA
#undef PG8_LDB
#undef PG8_MMA
#undef PG8_WAIT_V
#undef PG8_WAIT_L
#undef PG8_BAR
#undef PG8_SCHED
}
}
constexpr int D = 1024, NB = 8, NSEQ = 2048, LCTX = 256, DEPTH = 2;
constexpr int R_CTX = NB * LCTX, R_LAT = NB * NSEQ, R_ALL = R_CTX + R_LAT;
constexpr int IN_COLS = 6400, PCOLS = 5888;
constexpr int HM_COLS = 2816, GATE_LD = 3072;
constexpr int PC_QA = 0, PC_KA = 512, PC_VA = 640, PC_QR = 768, PC_KR = 1280, PC_VR = 1792, PC_GR = 2304, PC_GATE = 2816;
constexpr int OC_FU = 2816, OC_GATE = 3328;
constexpr int NEXP = 32, EH = 512;
constexpr int P_ROWS = 2 * R_ALL + 256;
constexpr size_t MiB = 1u << 20, KiB = 1u << 10;
constexpr size_t WS_CTL = 0, CTL_BYTES = 256 * KiB;
constexpr size_t WS_TAB = 256 * KiB, WS_MODS = 832 * KiB, WS_ROUTE = 1264 * KiB, WS_FL = 1904 * KiB, WS_UTC = 2304 * KiB, WS_FN = WS_UTC + 4 * MiB;
constexpr size_t WS_WSMALL = WS_FN + 16 * MiB, WSMALL_LAYER = (size_t)(18.5 * MiB);
constexpr size_t WO_WIN = 0, WO_WF = (size_t)(11.5 * MiB), WO_WBA = (size_t)(13.5 * MiB), WO_WBF = (size_t)(14.5 * MiB), WO_WBR = (size_t)(15.5 * MiB), WO_WOUT = (size_t)(16.5 * MiB);
constexpr size_t WS_WGU = WS_WSMALL + 37 * MiB, WS_WD = WS_WGU + 64 * MiB;
constexpr size_t WS_H = WS_WD + 32 * MiB;
constexpr size_t WS_SST = WS_H + 36 * MiB;
constexpr size_t WS_OA = WS_SST + 18 * MiB, WS_OF = WS_OA + 18 * MiB, WS_UT = WS_OF + 18 * MiB, WS_RET = WS_UT + 32 * MiB;
constexpr size_t WS_XL = WS_RET + 18 * MiB;
constexpr size_t WS_W0GU = WS_XL + 36 * MiB, WS_W0D = WS_W0GU + 64 * MiB;
constexpr size_t WS_PROJ = WS_W0GU + 24 * MiB;
constexpr size_t WS_XG = WS_PROJ, WS_ACT = WS_XG + (size_t)P_ROWS * 1024 * 2, WS_YS = WS_ACT + (size_t)P_ROWS * 512 * 2;
constexpr size_t WS_END = WS_PROJ + (size_t)R_ALL * PCOLS * 2;
static_assert(WS_W0D + 32 * MiB <= WS_XG + (size_t)P_ROWS * 1024 * 2 && WS_W0D + 32 * MiB <= WS_PROJ + (size_t)HM_COLS * R_ALL * 2, "layer-0 expert weights end inside the dead head-major part of proj, below the act buffer");
static_assert(WS_YS + (size_t)P_ROWS * 1024 * 2 <= WS_END, "MoE buffers fit in the proj region");
static_assert(WS_END <= 602284512ull, "workspace map must fit sum(inputs) bytes");
static_assert(WS_TAB + (16384 + 2 * 65536) * 4 <= WS_MODS && WS_MODS + 2 * 9 * 6144 * 4 <= WS_ROUTE && WS_ROUTE + 640 * KiB <= WS_FL && WS_FL + 256 * KiB <= WS_UTC, "small regions");
constexpr int CW_BLK = 16384;
constexpr int CW_BAR = 4096;
constexpr int CW_PANEL = 49152;
constexpr int CW_FLAG = 32768;
constexpr int TB_ROWC = 0, TB_ROWS = 512, TB_COLC = 1024, TB_COLS = 2048, TB_LG = 3072  , TB_RETC = 16384, TB_RETS = 16384 + 65536;
constexpr size_t RT_TOKE = 0, RT_TOKW = 160 * 1024, RT_SDST = 320 * 1024, RT_SW = 480 * 1024;
constexpr int LDS_BYTES = 155648;
constexpr int LDS_TBL = 131072;

struct EpiStore {
    static constexpr bool PERM = true;
    DI bool operator()(f32x4 (&acc)[2][2][4][2], const pg8::Unit& u, int wr, int wc, int fr_, int fq_) const {
        int fr = fr_, fq = fq_; asm volatile("" : "+v"(fr), "+v"(fq));
        bf16_t* O = (bf16_t*)u.o0; const int ld = u.ld; const bool hm = u.flag == 2;
#pragma unroll
        for (int ai = 0; ai < 2; ++ai)
#pragma unroll
            for (int m = 0; m < 4; ++m) { const int r = ai * 128 + wr * 64 + m * 16 + fr;
                if (hm) {
#pragma unroll
                    for (int bj = 0; bj < 2; ++bj) { const int cc = bj * 128 + wc * 32 + 8 * fq; const f32x4 v0 = acc[ai][bj][m][0], v1 = acc[ai][bj][m][1];
                        u32x4 w; w.x = pk2(v0[0], v0[1]); w.y = pk2(v0[2], v0[3]); w.z = pk2(v1[0], v1[1]); w.w = pk2(v1[2], v1[3]);
                        *(u32x4*)(O + ((size_t)(cc >> 6) * R_ALL + r) * 64 + (cc & 63)) = w; }
                } else
                if (r < u.rows) { bf16_t* rowp = O + (size_t)r * ld + wc * 32 + 8 * fq;
#pragma unroll
                    for (int bj = 0; bj < 2; ++bj) { const f32x4 v0 = acc[ai][bj][m][0], v1 = acc[ai][bj][m][1];
                        u32x4 w; w.x = pk2(v0[0], v0[1]); w.y = pk2(v0[2], v0[3]); w.z = pk2(v1[0], v1[1]); w.w = pk2(v1[2], v1[3]);
                        *(u32x4*)(rowp + bj * 128) = w; } } }
        return false;
    }
};
struct EpiNone { static constexpr bool PERM = true; DI bool operator()(f32x4 (&acc)[2][2][4][2], const pg8::Unit& u, int wr, int wc, int fr, int fq) const {
#pragma unroll
    for (int a = 0; a < 2; ++a)
#pragma unroll
        for (int b = 0; b < 2; ++b)
#pragma unroll
            for (int m = 0; m < 4; ++m)
#pragma unroll
                for (int n = 0; n < 2; ++n) asm volatile("" :: "v"(acc[a][b][m][n])); return false; } };
struct EpiMerge {
    static constexpr bool PERM = true;
    DI bool operator()(f32x4 (&acc)[2][2][4][2], const pg8::Unit& u, int wr, int wc, int fr_, int fq_) const {
        int fr = fr_, fq = fq_; asm volatile("" : "+v"(fr), "+v"(fq));
        bf16_t* M = (bf16_t*)u.o0; const bf16_t* G = (const bf16_t*)u.o1; const int br = u.flag;
        if (br < 2) {
#pragma unroll
            for (int ai = 0; ai < 2; ++ai) {
                u32x4 gc[4][2], gn[4][2];
#pragma unroll
                for (int m = 0; m < 4; ++m) { const int r = ai * 128 + wr * 64 + m * 16 + fr;
#pragma unroll
                    for (int bj = 0; bj < 2; ++bj) { const bf16_t* gp = G + (size_t)r * GATE_LD + wc * 32 + 8 * fq + bj * 128; gc[m][bj] = *(const u32x4*)gp; gn[m][bj] = *(const u32x4*)(gp + 1024); } }
#pragma unroll
                for (int m = 0; m < 4; ++m)
#pragma unroll
                    for (int bj = 0; bj < 2; ++bj) { const u32x4 c = gc[m][bj], n = gn[m][bj];
#define RATIO(xc, xn) ((1.0f + __expf(-fminf(fmaxf((xn), -30.f), 30.f))) * __builtin_amdgcn_rcpf(1.0f + __expf(-fminf(fmaxf((xc), -30.f), 30.f))))
                        f32x4& v0 = acc[ai][bj][m][0]; f32x4& v1 = acc[ai][bj][m][1];
                        v0[0] *= RATIO(bflo(c.x), bflo(n.x)); v0[1] *= RATIO(bfhi(c.x), bfhi(n.x)); v0[2] *= RATIO(bflo(c.y), bflo(n.y)); v0[3] *= RATIO(bfhi(c.y), bfhi(n.y));
                        v1[0] *= RATIO(bflo(c.z), bflo(n.z)); v1[1] *= RATIO(bfhi(c.z), bfhi(n.z)); v1[2] *= RATIO(bflo(c.w), bflo(n.w)); v1[3] *= RATIO(bfhi(c.w), bfhi(n.w));
#undef RATIO
                    }
            }
            return true;
        }
#pragma unroll
        for (int ai = 0; ai < 2; ++ai) {
            u32x4 gq[4][2];
#pragma unroll
            for (int m = 0; m < 4; ++m) { const int r = ai * 128 + wr * 64 + m * 16 + fr;
#pragma unroll
                for (int bj = 0; bj < 2; ++bj) gq[m][bj] = *(const u32x4*)(G + (size_t)r * GATE_LD + wc * 32 + 8 * fq + bj * 128); }
#pragma unroll
            for (int m = 0; m < 4; ++m) { const int r = ai * 128 + wr * 64 + m * 16 + fr; bf16_t* mp = M + (size_t)r * 1024 + wc * 32 + 8 * fq;
#pragma unroll
                for (int bj = 0; bj < 2; ++bj) { const f32x4 v0 = acc[ai][bj][m][0], v1 = acc[ai][bj][m][1]; const u32x4 g = gq[m][bj];
#define SG(x) sigmoidf_(fminf(fmaxf((x), -30.f), 30.f))
                    u32x4 w; w.x = pk2(SG(bflo(g.x)) * v0[0], SG(bfhi(g.x)) * v0[1]); w.y = pk2(SG(bflo(g.y)) * v0[2], SG(bfhi(g.y)) * v0[3]);
                    w.z = pk2(SG(bflo(g.z)) * v1[0], SG(bfhi(g.z)) * v1[1]); w.w = pk2(SG(bflo(g.w)) * v1[2], SG(bfhi(g.w)) * v1[3]);
#undef SG
                    *(u32x4*)(mp + bj * 128) = w; } }
        }
        return false;
    }
};
struct EpiOut {
    static constexpr bool PERM = true;
    DI bool operator()(f32x4 (&acc)[2][2][4][2], const pg8::Unit& u, int wr, int wc, int fr_, int fq_) const {
        int fr = fr_, fq = fq_; asm volatile("" : "+v"(fr), "+v"(fq));
        bf16_t* Dst = (bf16_t*)u.o0; const float* gvec = (const float*)u.o2; const bool f32src = u.flag != 0;
        f32x4 gv[2][2];
#pragma unroll
        for (int bj = 0; bj < 2; ++bj)
#pragma unroll
            for (int n = 0; n < 2; ++n) gv[bj][n] = *(const f32x4*)(gvec + bj * 128 + wc * 32 + 8 * fq + 4 * n);
#pragma unroll
        for (int ai = 0; ai < 2; ++ai) {
            f32x4 sv[4][2][2];
#pragma unroll
            for (int m = 0; m < 4; ++m) { const int r = ai * 128 + wr * 64 + m * 16 + fr;
#pragma unroll
                for (int bj = 0; bj < 2; ++bj) { const size_t off = (size_t)r * 1024 + bj * 128 + wc * 32 + 8 * fq;
                    if (f32src) { const float* sp = (const float*)u.o1 + off; sv[m][bj][0] = *(const f32x4*)sp; sv[m][bj][1] = *(const f32x4*)(sp + 4); }
                    else { const u32x4 q = *(const u32x4*)((const bf16_t*)u.o1 + off); sv[m][bj][0] = (f32x4){bflo(q.x), bfhi(q.x), bflo(q.y), bfhi(q.y)}; sv[m][bj][1] = (f32x4){bflo(q.z), bfhi(q.z), bflo(q.w), bfhi(q.w)}; } } }
#pragma unroll
            for (int m = 0; m < 4; ++m) { const int r = ai * 128 + wr * 64 + m * 16 + fr;
#pragma unroll
                for (int bj = 0; bj < 2; ++bj) { const f32x4 v0 = sv[m][bj][0] + gv[bj][0] * acc[ai][bj][m][0], v1 = sv[m][bj][1] + gv[bj][1] * acc[ai][bj][m][1];
                    u32x4 w; w.x = pk2(v0[0], v0[1]); w.y = pk2(v0[2], v0[3]); w.z = pk2(v1[0], v1[1]); w.w = pk2(v1[2], v1[3]);
                    *(u32x4*)(Dst + (size_t)r * 1024 + bj * 128 + wc * 32 + 8 * fq) = w; } }
        }
        return false;
    }
};
struct EpiGU {
    static constexpr bool PERM = true;
    DI bool operator()(f32x4 (&acc)[2][2][4][2], const pg8::Unit& u, int wr, int wc, int fr_, int fq_) const {
        int fr = fr_, fq = fq_; asm volatile("" : "+v"(fr), "+v"(fq));
        bf16_t* O = (bf16_t*)u.o0;
#pragma unroll
        for (int ai = 0; ai < 2; ++ai)
#pragma unroll
            for (int m = 0; m < 4; ++m) { const int r = ai * 128 + wr * 64 + m * 16 + fr;
                if (r < u.rows) { bf16_t* rowp = O + (size_t)r * 512 + wc * 16 + 4 * fq;
#pragma unroll
                    for (int bj = 0; bj < 2; ++bj) { const f32x4 g = acc[ai][bj][m][0], v = acc[ai][bj][m][1];
                        u32x2 w; w.x = pk2(siluf_(g[0]) * v[0], siluf_(g[1]) * v[1]); w.y = pk2(siluf_(g[2]) * v[2], siluf_(g[3]) * v[3]);
                        *(u32x2*)(rowp + bj * 64) = w; } } }
        return false;
    }
};
struct EpiDown {
    static constexpr bool PERM = true;
    DI bool operator()(f32x4 (&acc)[2][2][4][2], const pg8::Unit& u, int wr, int wc, int fr_, int fq_) const {
        int fr = fr_, fq = fq_; asm volatile("" : "+v"(fr), "+v"(fq));
        bf16_t* Y = (bf16_t*)u.o0; const float* sw = (const float*)u.o2;
        float ww[2][4];
#pragma unroll
        for (int ai = 0; ai < 2; ++ai)
#pragma unroll
            for (int m = 0; m < 4; ++m) { const int r = ai * 128 + wr * 64 + m * 16 + fr; ww[ai][m] = (r < u.rows) ? sw[r] : 0.f; }
#pragma unroll
        for (int ai = 0; ai < 2; ++ai)
#pragma unroll
            for (int m = 0; m < 4; ++m) { const int r = ai * 128 + wr * 64 + m * 16 + fr;
                if (r < u.rows) { const float wt = ww[ai][m]; bf16_t* rowp = Y + (size_t)r * 1024 + wc * 32 + 8 * fq;
#pragma unroll
                    for (int bj = 0; bj < 2; ++bj) { const f32x4 v0 = acc[ai][bj][m][0] * wt, v1 = acc[ai][bj][m][1] * wt;
                        u32x4 w; w.x = pk2(v0[0], v0[1]); w.y = pk2(v0[2], v0[3]); w.z = pk2(v1[0], v1[1]); w.w = pk2(v1[2], v1[3]);
                        *(u32x4*)(rowp + bj * 128) = w; } } }
        return false;
    }
};

DI void tile_of(int L, int nM, int nN, int& pm, int& pn) {
    const int nwg = nM * nN;
    int wgid = L; { const int q = nwg / 8, r = nwg % 8, xcd = wgid % 8, off = wgid / 8; wgid = (xcd < r ? xcd * (q + 1) : r * (q + 1) + (xcd - r) * q) + off; }
    const int nig = 4 * nN, gid = wgid / nig, fm = gid * 4, gsz = (nM - fm) < 4 ? (nM - fm) : 4;
    pm = fm + ((wgid % nig) % gsz); pn = (wgid % nig) / gsz;
}
DI int xcd_remap(int L, int nwg) { const int q = nwg / 8, r = nwg % 8, xcd = L % 8, off = L / 8; return (xcd < r ? xcd * (q + 1) : r * (q + 1) + (xcd - r) * q) + off; }
struct Params { const float* in[24]; float* out; unsigned char* ws; int ph_lo, ph_hi; };
typedef __attribute__((address_space(4))) const Params* KParams;
struct Ctx {
    KParams P; float* out; unsigned char* ws;
    DI const float* in(int i) const { return P->in[i]; }
    int G, c, tid;
};
DI const bf16_t* PJ(const bf16_t* proj, int row, int col) { return proj + ((size_t)(col >> 6) * R_ALL + row) * 64 + (col & 63); }
DI bf16_t* wsmall(const Ctx& X, int l, size_t off) { return (bf16_t*)(X.ws + WS_WSMALL + (size_t)l * WSMALL_LAYER + off); }

struct SchedA {
    const Ctx* X; int l; int n_main, n_ctx, n_f, ftok0, nftok;
    DI void init(const Ctx* X_, int l_) { X = X_; l = l_;
        if (l == 0) { n_main = 72 * 23; n_ctx = 0; ftok0 = 0; nftok = 72; } else { n_main = 64 * 23; n_ctx = 8 * 5; ftok0 = 8; nftok = 64; }
        n_f = 4 * nftok; }
    DI bool next(int i, pg8::Unit& u) const {
        int L = i * X->G + X->c;
        const bf16_t* h = (const bf16_t*)(X->ws + WS_H); bf16_t* proj = (bf16_t*)(X->ws + WS_PROJ);
        u.rows = 256; u.flag = 0; u.o1 = nullptr; u.o2 = nullptr; u.gidx = nullptr;
        if (L < n_main) { int pm, pn; tile_of(L, l == 0 ? 72 : 64, 23, pm, pn); if (l != 0) pm += 8;
            u.a = (const char*)(h + (size_t)pm * 256 * 1024); u.b = (const char*)(wsmall(*X, l, WO_WIN) + (size_t)pn * 256 * 1024);
            if (pn < 11) { u.o0 = proj + ((size_t)(pn * 4) * R_ALL + pm * 256) * 64; u.ld = 64; u.flag = 2; } else { u.o0 = proj + (size_t)HM_COLS * R_ALL + (size_t)pm * 256 * GATE_LD + (pn - 11) * 256; u.ld = GATE_LD; }
            return true; }
        L -= n_main;
        if (L < n_ctx) { const int pm = L / 5, j = L % 5, pn = (j == 0) ? 2 : 4 + j;
            u.a = (const char*)(h + (size_t)pm * 256 * 1024); u.b = (const char*)(wsmall(*X, l, WO_WIN) + (size_t)pn * 256 * 1024);
            u.o0 = proj + ((size_t)(pn * 4) * R_ALL + pm * 256) * 64; u.ld = 64; u.flag = 2; return true; }
        L -= n_ctx;
        if (L < n_f) { const int w = xcd_remap(L, n_f); const int tt = ftok0 + w / 4, pm = w % 4, cs = pm >> 1, colbase = (pm & 1) * 256;
            u.a = (const char*)(wsmall(*X, l, WO_WF) + (size_t)pm * 256 * 1024); u.b = (const char*)(h + (size_t)tt * 256 * 1024);
            if (tt < 8) { u.o0 = (bf16_t*)(X->ws + WS_UTC) + ((size_t)(tt * 512 + colbase)) * 512 + cs * 256; u.ld = 512; }
            else { const int tl = tt - 8, bb = tl >> 3, n0 = (tl & 7) * 256; u.o0 = (bf16_t*)(X->ws + WS_UT) + ((size_t)(bb * 512 + colbase)) * 4096 + cs * 2048 + n0; u.ld = 4096; }
            return true; }
        return false;
    }
};
struct SchedF2 {
    const Ctx* X;
    DI bool next(int i, pg8::Unit& u) const {
        if (i != 0 || X->c >= 128) return false;
        const int L = X->c, b = L >> 4, pm = (L >> 1) & 7, pn = L & 1;
        u.a = (const char*)((const bf16_t*)(X->ws + WS_FN) + (size_t)pm * 256 * 2048); u.b = (const char*)((const bf16_t*)(X->ws + WS_UT) + ((size_t)(b * 512 + pn * 256)) * 4096);
        u.o0 = (bf16_t*)(X->ws + WS_OF) + ((size_t)(R_CTX + b * 2048 + pm * 256)) * 512 + pn * 256; u.ld = 512; u.rows = 256; u.flag = 0; u.o1 = nullptr; u.o2 = nullptr; u.gidx = nullptr; return true;
    }
};
struct SchedF2c {
    const Ctx* X;
    DI bool next(int i, pg8::Unit& u) const {
        if (i != 0 || X->c < 128 || X->c >= 144) return false;
        const int L = X->c - 128, b = L >> 1, pn = L & 1;
        u.a = (const char*)(X->ws + WS_FL); u.b = (const char*)((const bf16_t*)(X->ws + WS_UTC) + ((size_t)(b * 512 + pn * 256)) * 512);
        u.o0 = (bf16_t*)(X->ws + WS_OF) + ((size_t)(b * 256)) * 512 + pn * 256; u.ld = 512; u.rows = 256; u.flag = 0; u.o1 = nullptr; u.o2 = nullptr; u.gidx = nullptr; return true;
    }
};
DI bool merge_tile(int l, int G, int c, int j, int& pm, int& pn) {
    if (l != 0) { if (j != 0 || c >= 256) return false; tile_of(c, 64, 4, pm, pn); pm += 8; return true; }
    if (c >= 32) { if (j != 0 || c - 32 >= 224) return false; tile_of(c - 32, 56, 4, pm, pn); return true; }
    if (j > 1) return false; const int t2 = c * 2 + j; pm = 56 + (t2 >> 2); pn = t2 & 3; return true;
}
struct SchedM {
    const Ctx* X; int l;
    DI void init(const Ctx* X_, int l_) { X = X_; l = l_; }
    DI bool next(int i, pg8::Unit& u) const {
        const int br = i % 3; int pm, pn; if (!merge_tile(l, X->G, X->c, i / 3, pm, pn)) return false;
        const size_t src = (br == 0) ? WS_OA : (br == 1) ? WS_OF : WS_RET; const size_t wo = (br == 0) ? WO_WBA : (br == 1) ? WO_WBF : WO_WBR;
        u.a = (const char*)((const bf16_t*)(X->ws + src) + (size_t)pm * 256 * 512); u.b = (const char*)(wsmall(*X, l, wo) + (size_t)pn * 256 * 512);
        u.o0 = (bf16_t*)(X->ws + WS_H) + (size_t)pm * 256 * 1024 + pn * 256;
        u.o1 = (const bf16_t*)(X->ws + WS_PROJ) + (size_t)HM_COLS * R_ALL + (size_t)pm * 256 * GATE_LD + br * 1024 + pn * 256; u.o2 = nullptr; u.ld = 1024; u.rows = 256; u.flag = br; u.gidx = nullptr; return true;
    }
};
struct SchedO {
    const Ctx* X; int l;
    DI void init(const Ctx* X_, int l_) { X = X_; l = l_; }
    DI bool unit_tile(int i, int& pm, int& pn) const {
        if (l != 0) { if (i != 0) return false; tile_of(X->c, 64, 4, pm, pn); pm += 8; return true; }
        const int idx = X->c - 32; if (idx < 0) return false;
        if (i == 0) { tile_of(idx, 56, 4, pm, pn); return true; }
        if (i == 1 && idx < 64) { pm = 56 + (idx >> 2); pn = idx & 3; return true; }
        return false; }
    DI int panel_of(int i) const { int pm, pn; return unit_tile(i, pm, pn) ? pm : -1; }
    DI bool next(int i, pg8::Unit& u) const {
        int pm, pn; if (!unit_tile(i, pm, pn)) return false;
        u.a = (const char*)((const bf16_t*)(X->ws + WS_H) + (size_t)pm * 256 * 1024); u.b = (const char*)(wsmall(*X, l, WO_WOUT) + (size_t)pn * 256 * 1024);
        bf16_t* xl = (bf16_t*)(X->ws + WS_XL) + (size_t)pm * 256 * 1024 + pn * 256;
        const void* src = (l != 0) ? (const void*)xl : (const void*)(pm < 8 ? X->in(2) + (size_t)pm * 256 * 1024 + pn * 256 : X->in(0) + (size_t)(pm - 8) * 256 * 1024 + pn * 256);
        const int bidx = pm < 8 ? 8 : (pm - 8) >> 3;
        u.o0 = xl; u.o1 = src; u.o2 = (const float*)(X->ws + WS_MODS) + ((size_t)(l * 9 + bidx) * 6 + 2) * 1024 + pn * 256; u.ld = 1024; u.rows = 256; u.flag = (l == 0); u.gidx = nullptr; return true;
    }
};
DI unsigned* panel_cnt(const Ctx& X, int l, int pm) { return (unsigned*)(X.ws + WS_CTL) + CW_PANEL + (l * 72 + pm) * 64; }
DI void merge_publish(const Ctx& X, int l) {
    asm volatile("s_waitcnt vmcnt(0)" ::: "memory");
    __syncthreads();
    if (X.tid == 0) { __builtin_amdgcn_fence(__ATOMIC_RELEASE, "agent"); asm volatile("s_waitcnt vmcnt(0)" ::: "memory");
        for (int j = 0; j < 2; ++j) { int pm, pn; if (!merge_tile(l, X.G, X.c, j, pm, pn)) break; __hip_atomic_fetch_add(panel_cnt(X, l, pm), 1u, __ATOMIC_RELAXED, __HIP_MEMORY_SCOPE_AGENT); } }
}
DI void out_wait(const Ctx& X, const SchedO& S) {
    if (X.tid == 0) {
        for (int i = 0; i < 2; ++i) { const int pm = S.panel_of(i); if (pm < 0) break; unsigned* f = panel_cnt(X, S.l, pm); unsigned sp = 0;
            while (__hip_atomic_load(f, __ATOMIC_RELAXED, __HIP_MEMORY_SCOPE_AGENT) < 4u) { __builtin_amdgcn_s_sleep(2); if (++sp > (1u << 22)) break; } }
        __builtin_amdgcn_fence(__ATOMIC_ACQUIRE, "agent"); asm volatile("s_waitcnt vmcnt(0)" ::: "memory"); }
    __syncthreads();
}
struct SchedE {
    const Ctx* X; const LAS int* tb; int which, l;
    DI bool next(int i, pg8::Unit& u) const {
        const int ntile = tb[96], nwg = ntile * 4; const int L = i * X->G + X->c; if (L >= nwg) return false;
        const int w = xcd_remap(L, nwg), T = w >> 2, pn = w & 3;
        int e = 0;
#pragma unroll 1
        for (int k = 1; k < 32; ++k) if (tb[64 + k] <= T) e = k;
        const int j = T - tb[64 + e], row0 = tb[e] + 256 * j; int rows = tb[32 + e] - 256 * j; rows = rows > 256 ? 256 : rows;
        u.rows = rows; u.flag = 0; u.gidx = (const int*)(X->ws + WS_ROUTE + RT_SDST) + row0;
        if (which == 1) { u.a = (const char*)(X->ws + WS_H); u.b = (const char*)((const bf16_t*)(X->ws + (l == 0 ? WS_W0GU : WS_WGU)) + ((size_t)e * 1024 + pn * 256) * 1024);
            u.o0 = (bf16_t*)(X->ws + WS_ACT) + (size_t)row0 * 512 + pn * 128; u.o1 = nullptr; u.o2 = nullptr; u.ld = 512; }
        else { u.a = (const char*)((const bf16_t*)(X->ws + WS_ACT) + (size_t)row0 * 512); u.b = (const char*)((const bf16_t*)(X->ws + (l == 0 ? WS_W0D : WS_WD)) + ((size_t)e * 1024 + pn * 256) * 512);
            u.o0 = (bf16_t*)(X->ws + WS_YS) + (size_t)row0 * 1024 + pn * 256; u.o1 = nullptr; u.o2 = (const float*)(X->ws + WS_ROUTE + RT_SW) + row0; u.ld = 1024; }
        return true;
    }
};
DI void build_expert_table(const Ctx& X, int l, LAS int* tb) {
    const unsigned* blk = (const unsigned*)(X.ws + WS_CTL) + CW_BLK + l * 8192;
    LAS int* ps = tb + 256;
    { const int e = X.tid & 31, part = X.tid >> 5; int tot = 0, pre = 0;
#pragma unroll 4
      for (int b = part * 16; b < part * 16 + 16; ++b) { const int v = (int)__hip_atomic_load(blk + b * 32 + e, __ATOMIC_RELAXED, __HIP_MEMORY_SCOPE_AGENT); tot += v; pre += (b < X.c) ? v : 0; }
      ps[(part * 2 + 0) * 32 + e] = tot; ps[(part * 2 + 1) * 32 + e] = pre; }
    __syncthreads();
    if (X.tid < 32) { int tot = 0, pre = 0;
        for (int part = 0; part < 16; ++part) { tot += ps[(part * 2 + 0) * 32 + X.tid]; pre += ps[(part * 2 + 1) * 32 + X.tid]; }
        tb[32 + X.tid] = tot; tb[128 + X.tid] = pre; tb[160 + X.tid] = 0; }
    __syncthreads();
    if (X.tid == 0) { int base = 0, tp = 0;
        for (int e = 0; e < 32; ++e) { const int c = tb[32 + e]; tb[e] = base; tb[128 + e] += base; tb[64 + e] = tp; base += c; tp += (c + 255) >> 8; }
        tb[96] = tp; }
    __syncthreads();
}
template <class RowMap>
DI void transpose_item(const float* W, int ldw, int K, bf16_t* WT, int k0, int n0, float scale, const RowMap& rowmap, float* scr, int lane) {
    float tv[32];
#pragma unroll
    for (int i = 0; i < 32; ++i) tv[i] = W[(size_t)(k0 + 2 * i + (lane >> 5)) * ldw + n0 + (lane & 31)];
#pragma unroll
    for (int i = 0; i < 32; ++i) scr[(2 * i + (lane >> 5)) * 33 + (lane & 31)] = tv[i];
    asm volatile("s_waitcnt lgkmcnt(0)" ::: "memory");
    const int c = lane & 7;
#pragma unroll
    for (int j = 0; j < 4; ++j) { const int n = (lane >> 3) + 8 * j; const float* s = scr + (8 * c) * 33 + n;
        u32x4 o; o.x = pk2(s[0 * 33] * scale, s[1 * 33] * scale); o.y = pk2(s[2 * 33] * scale, s[3 * 33] * scale); o.z = pk2(s[4 * 33] * scale, s[5 * 33] * scale); o.w = pk2(s[6 * 33] * scale, s[7 * 33] * scale);
        *(u32x4*)(WT + (size_t)rowmap(n0 + n) * K + k0 + 8 * c) = o; }
    asm volatile("s_waitcnt lgkmcnt(0)" ::: "memory");
}
struct RowId { int off; DI int operator()(int n) const { return n + off; } };
struct RowGU { int gu; DI int operator()(int j) const { return 8 * (j >> 2) + 4 * gu + (j & 3); } };

DI void small_weights(const Ctx& X, char* lds, int l, int c_first, int c_count) {
    if (X.c < c_first || X.c >= c_first + c_count) return;
    const int tid = X.tid, lane = tid & 63, wave = tid >> 6; const int gw = (X.c - c_first) * 8 + wave, NGW = c_count * 8;
    __syncthreads();
    { float* scr = (float*)(lds + wave * 8704);
      constexpr int I_WIN = 16 * (PCOLS / 32), I_WB = 8 * 32, I_WO = 16 * 32, I_L = I_WIN + 3 * I_WB + I_WO;
      for (int it = gw; it < I_L; it += NGW) {
          int r = it;
          if (r < I_WIN) { const int kb = r / (PCOLS / 32), nb = r % (PCOLS / 32), n0 = nb * 32; const int o0 = n0 < PC_GATE ? n0 : n0 + 512;
              const float scale = (n0 < PC_KA || (n0 >= PC_KR && n0 < PC_VR)) ? 0.125f : 1.0f;
              transpose_item(X.in(8) + (size_t)l * 1024 * IN_COLS, IN_COLS, 1024, wsmall(X, l, WO_WIN), kb * 64, o0, scale, RowId{n0 - o0}, scr, lane); continue; }
          r -= I_WIN;
          if (r < 3 * I_WB) { const int br = r / I_WB, q = r % I_WB, kb = q / 32, nb = q % 32;
              const float* pb0 = (X.in(12)); const float* pb1 = (X.in(13)); const float* pb2 = (X.in(14));
              transpose_item((br == 0 ? pb0 : br == 1 ? pb1 : pb2) + (size_t)l * 512 * 1024, 1024, 512, wsmall(X, l, br == 0 ? WO_WBA : br == 1 ? WO_WBF : WO_WBR), kb * 64, nb * 32, 1.0f, RowId{0}, scr, lane); continue; }
          r -= 3 * I_WB;
          { const int kb = r / 32, nb = r % 32; transpose_item(X.in(15) + (size_t)l * 1024 * 1024, 1024, 1024, wsmall(X, l, WO_WOUT), kb * 64, nb * 32, 1.0f, RowId{0}, scr, lane); }
      } }
    __syncthreads();
    { float* t128 = (float*)lds;
      float* wt = (float*)(lds + 1024);
      const int fr = lane & 15, fq = lane >> 4;
      if (tid < 128) { const float rev = (float)tid * (1.0f / 128.0f); t128[tid] = __builtin_amdgcn_cosf(rev) * 0.08838834764831845f; t128[128 + tid] = __builtin_amdgcn_sinf(rev) * 0.08838834764831845f; }
      for (int it = X.c - c_first; it < 4 * 32; it += c_count) {
          const int g = (it >> 5) & 3, k0 = (it & 31) * 32;
          __syncthreads();
          { const float* wsrc = X.in(8) + ((size_t)l * 1024 + k0) * IN_COLS + OC_FU + g * 128;
#pragma unroll
            for (int i = 0; i < 2; ++i) { const int e = tid + 512 * i, kk = e >> 5, c4 = e & 31; *(f32x4*)(wt + kk * 132 + 4 * c4) = *(const f32x4*)(wsrc + (size_t)kk * IN_COLS + 4 * c4); } }
          __syncthreads();
          f32x4 acc[2][2];
#pragma unroll
          for (int rt = 0; rt < 2; ++rt)
#pragma unroll
              for (int ct = 0; ct < 2; ++ct) acc[rt][ct] = (f32x4){0.f, 0.f, 0.f, 0.f};
#pragma unroll
          for (int s = 0; s < 4; ++s) {
              bf16x8 af[2], bfr[2];
#pragma unroll
              for (int rt = 0; rt < 2; ++rt) { const int R = 32 * wave + 16 * rt + fr, cs = R >> 7, j = R & 127; const float* T = t128 + cs * 128; float v[8];
#pragma unroll
                  for (int q = 0; q < 8; ++q) v[q] = T[((32 * s + 8 * fq + q) * j) & 127];
                  u32x4 w; w.x = pk2(v[0], v[1]); w.y = pk2(v[2], v[3]); w.z = pk2(v[4], v[5]); w.w = pk2(v[6], v[7]); af[rt] = __builtin_bit_cast(bf16x8, w); }
#pragma unroll
              for (int ct = 0; ct < 2; ++ct) { const float* wp = wt + (16 * ct + fr) * 132 + 32 * s + 8 * fq; const f32x4 w0 = *(const f32x4*)wp, w1 = *(const f32x4*)(wp + 4);
                  u32x4 w; w.x = pk2(w0[0], w0[1]); w.y = pk2(w0[2], w0[3]); w.z = pk2(w1[0], w1[1]); w.w = pk2(w1[2], w1[3]); bfr[ct] = __builtin_bit_cast(bf16x8, w); }
#pragma unroll
              for (int rt = 0; rt < 2; ++rt)
#pragma unroll
                  for (int ct = 0; ct < 2; ++ct) acc[rt][ct] = __builtin_amdgcn_mfma_f32_16x16x32_bf16(af[rt], bfr[ct], acc[rt][ct], 0, 0, 0);
          }
          bf16_t* WF = wsmall(X, l, WO_WF);
#pragma unroll
          for (int rt = 0; rt < 2; ++rt)
#pragma unroll
              for (int ct = 0; ct < 2; ++ct)
#pragma unroll
                  for (int q = 0; q < 4; ++q) { const int R = 32 * wave + 16 * rt + 4 * fq + q, np = (R >> 7) * 512 + g * 128 + (R & 127); WF[(size_t)np * 1024 + k0 + 16 * ct + fr] = f2bf(acc[rt][ct][q]); }
      }
      __syncthreads(); }
}

DI void phase_prologue(const Ctx& X, char* lds) {
    const int tid = X.tid, lane = tid & 63, wave = tid >> 6;
    const int gw = X.c * 8 + wave, NGW = X.G * 8; const int gt = X.c * 512 + tid, NGT = X.G * 512;
    float* tab = (float*)(X.ws + WS_TAB);
    for (int e = gt; e < 512 + 1024 + 65536 + 32; e += NGT) {
        if (e < 512 + 1024 + 65536) {
            int pos, f, nf; float* cdst; float* sdst;
            if (e < 512) { pos = e >> 4; f = e & 15; nf = 16; cdst = tab + TB_ROWC + e; sdst = tab + TB_ROWS + e; }
            else if (e < 1536) { const int q = e - 512; pos = q >> 4; f = q & 15; nf = 16; cdst = tab + TB_COLC + q; sdst = tab + TB_COLS + q; }
            else { const int q = e - 1536; pos = q >> 5; f = q & 31; nf = 32; cdst = tab + TB_RETC + q; sdst = tab + TB_RETS + q; }
            const float inv = exp2f(-(float)f / (float)nf * 13.287712379549449f);
            double s, c; sincos_d((double)((float)pos * inv), s, c); *cdst = (float)c; *sdst = (float)s;
        } else { const int q = e - (512 + 1024 + 65536); const int l = q >> 4, dir = (q >> 3) & 1, hh = q & 7;
            const float* pdf = (X.in(10)); const float* pdb = (X.in(11)); const float xlog = (dir == 0 ? pdf : pdb)[l * 8 + hh];
            const double lg = -log1p(exp(-(double)xlog));
            tab[TB_LG + q] = (float)(lg * 1.4426950408889634); }
    }
    { bf16_t* FN = (bf16_t*)(X.ws + WS_FN); bf16_t* FL = (bf16_t*)(X.ws + WS_FL);
      const int nFN = 2048 * 2048 / 8, nFL = 256 * 512 / 8;
      for (int it = gt; it < nFN + nFL; it += NGT) {
          float v[8]; bf16_t* dst;
          if (it < nFN) { const int k = it >> 8, j0 = (it & 255) * 8; dst = FN + (size_t)k * 2048 + j0; const double sc = 1.0 / sqrt(2048.0), w0 = 6.283185307179586476925 / 2048.0;
#pragma unroll
              for (int j = 0; j < 8; ++j) { const int jj = j0 + j; const bool is_sin = jj > 1024; const int n = is_sin ? jj - 1024 : jj; const int mm = (k * n) & 2047; double s, c; sincos_d(w0 * (double)mm, s, c); v[j] = (float)((is_sin ? -s : c) * sc); } }
          else { const int q = it - nFN, k = q >> 6, n0 = (q & 63) * 8; dst = FL + (size_t)k * 512 + n0; const bool is_sin = n0 >= 256; const int nn0 = is_sin ? n0 - 256 : n0; const double sc = 1.0 / 16.0, w0 = 6.283185307179586476925 / 256.0;
#pragma unroll
              for (int j = 0; j < 8; ++j) { const int mm = (k * (nn0 + j)) & 255; double s, c; sincos_d(w0 * (double)mm, s, c); v[j] = (float)((is_sin ? -s : c) * sc); } }
          u32x4 o; o.x = pk2(v[0], v[1]); o.y = pk2(v[2], v[3]); o.z = pk2(v[4], v[5]); o.w = pk2(v[6], v[7]); *(u32x4*)dst = o; } }
    { float* sv = (float*)lds;
      float* part = (float*)(lds + 36864);
      bool staged = false;
      for (int it = X.c; it < 2 * 96; it += X.G) {
          if (!staged) { for (int e = tid; e < 9 * 1024; e += 512) { const float v = (e < 8192) ? X.in(1)[e] : X.in(3)[e - 8192]; sv[e] = siluf_(v); } staged = true; }
          __syncthreads();
          const int l = it / 96, col = (it % 96) * 64 + lane; const float* W = X.in(6) + (size_t)l * 1024 * 6144;
          float acc[9];
#pragma unroll
          for (int r = 0; r < 9; ++r) acc[r] = 0.f;
          for (int k = wave * 128; k < wave * 128 + 128; ++k) { const float w = W[(size_t)k * 6144 + col];
#pragma unroll
              for (int r = 0; r < 9; ++r) acc[r] += sv[r * 1024 + k] * w; }
#pragma unroll
          for (int r = 0; r < 9; ++r) part[(wave * 9 + r) * 64 + lane] = acc[r];
          __syncthreads();
          for (int e = tid; e < 9 * 64; e += 512) { const int r = e >> 6, cc = e & 63; float s = 0.f;
#pragma unroll
              for (int w8 = 0; w8 < 8; ++w8) s += part[(w8 * 9 + r) * 64 + cc];
              const int cidx = (it % 96) * 64 + cc; ((float*)(X.ws + WS_MODS))[((size_t)(l * 9 + r)) * 6144 + cidx] = s + X.in(7)[l * 6144 + cidx]; }
      }
      __syncthreads(); }
    small_weights(X, lds, 0, 0, X.G);
}

constexpr int N_CONV_ITEMS = 32 * 768;
DI void convert_range(const Ctx& X, int l, char* lds, int item_lo, int item_hi, int c_first, int c_count) {
    if (X.c < c_first || X.c >= c_first + c_count) return;
    const int lane = X.tid & 63, wave = X.tid >> 6; const int gw = (X.c - c_first) * 8 + wave, NGW = c_count * 8;
    float* scr = (float*)(lds + wave * 8704);
    bf16_t* Wgu = (bf16_t*)(X.ws + (l == 0 ? WS_W0GU : WS_WGU)); bf16_t* Wd = (bf16_t*)(X.ws + (l == 0 ? WS_W0D : WS_WD));
    for (int it = item_lo + gw; it < item_hi; it += NGW) {
        int e, r;
        if (l != 0) { e = it / 768; r = it % 768; }
        else if (it < 6144) { e = it / 512; r = it % 512; }
        else if (it < 9216) { const int j = it - 6144; e = j / 256; r = 512 + j % 256; }
        else { const int k = it - 9216; e = 12 + k / 768; r = k % 768; }
        if (r < 512) { const int gu = r >> 8, q = r & 255, kb = q >> 4, nb = q & 15;
            const float* pg0 = (X.in(20)); const float* pg1 = (X.in(21));
            transpose_item((gu == 0 ? pg0 : pg1) + ((size_t)(l * 32 + e)) * 1024 * 512, 512, 1024, Wgu + (size_t)e * 1024 * 1024, kb * 64, nb * 32, 1.0f, RowGU{gu}, scr, lane); }
        else { const int q = r - 512, kb = q >> 5, nb = q & 31;
            transpose_item(X.in(22) + ((size_t)(l * 32 + e)) * 512 * 1024, 1024, 512, Wd + (size_t)e * 1024 * 512, kb * 64, nb * 32, 1.0f, RowId{0}, scr, lane); }
    }
}
constexpr int CV0_P1 = 6144;
constexpr int CV1_A = 7488, CV1_B = 16448;

DI void norm_mod_store(const f32x4 (&v)[4], const float* g, const float* sh, const float* sc, bf16_t* orow, int lane) {
    float ss = 0.f;
#pragma unroll
    for (int j = 0; j < 4; ++j) ss += (v[j].x * v[j].x + v[j].y * v[j].y) + (v[j].z * v[j].z + v[j].w * v[j].w);
    const float rstd = 1.0f / sqrtf(wave_sum(ss, lane) * (1.0f / 1024.0f) + 1e-6f);
#pragma unroll
    for (int j = 0; j < 4; ++j) { const int k = 4 * lane + 256 * j; const f32x4 gg = *(const f32x4*)(g + k), s1 = *(const f32x4*)(sh + k), s2 = *(const f32x4*)(sc + k);
        const f32x4 o = (v[j] * rstd * gg) * (s2 + 1.0f) + s1;
        u32x2 w; w.x = pk2(o.x, o.y); w.y = pk2(o.z, o.w); *(u32x2*)(orow + k) = w; }
}
DI const float* mod_vec(const Ctx& X, int l, int row, int which) { const int bidx = row < R_CTX ? 8 : (row - R_CTX) >> 11; return (const float*)(X.ws + WS_MODS) + ((size_t)(l * 9 + bidx) * 6 + which) * 1024; }

DI void phase_norm0(const Ctx& X) {
    const int lane = X.tid & 63, wave = X.tid >> 6; const int gw = X.c * 8 + wave, NGW = X.G * 8;
    for (int row0 = gw; row0 < R_ALL; row0 += 2 * NGW) {
        f32x4 v[2][4]; int rows[2];
#pragma unroll
        for (int q = 0; q < 2; ++q) { const int row = (row0 + q * NGW < R_ALL) ? row0 + q * NGW : row0; rows[q] = row;
            const float* xr = row < R_CTX ? X.in(2) + (size_t)row * 1024 : X.in(0) + (size_t)(row - R_CTX) * 1024;
#pragma unroll
            for (int j = 0; j < 4; ++j) v[q][j] = *(const f32x4*)(xr + 4 * lane + 256 * j); }
#pragma unroll
        for (int q = 0; q < 2; ++q) if (q == 0 || rows[1] != rows[0]) norm_mod_store(v[q], X.in(4), mod_vec(X, 0, rows[q], 0), mod_vec(X, 0, rows[q], 1), (bf16_t*)(X.ws + WS_H) + (size_t)rows[q] * 1024, lane);
    }
}
DI void phase_combine(const Ctx& X, int l) {
    const int lane = X.tid & 63, wave = X.tid >> 6; const int gw = X.c * 8 + wave, NGW = X.G * 8;
    const bool last = (l == DEPTH - 1); const int row_lo = last ? R_CTX : 0;
    for (int row0 = row_lo + gw; row0 < R_ALL; row0 += 2 * NGW) {
        f32x4 v[2][4]; int rows[2];
        u32x2 xq[2][4], ya[2][4], yb[2][4]; f32x4 gg[2][4];
#pragma unroll
        for (int q = 0; q < 2; ++q) { const int row = (row0 + q * NGW < R_ALL) ? row0 + q * NGW : row0; rows[q] = row;
            const bf16_t* xr = (const bf16_t*)(X.ws + WS_XL) + (size_t)row * 1024; const int* tsl = (const int*)(X.ws + WS_ROUTE + RT_TOKE) + row * 2;
            const bf16_t* y0 = (const bf16_t*)(X.ws + WS_YS) + (size_t)tsl[0] * 1024; const bf16_t* y1 = (const bf16_t*)(X.ws + WS_YS) + (size_t)tsl[1] * 1024;
            const float* g2 = mod_vec(X, l, row, 5);
#pragma unroll
            for (int j = 0; j < 4; ++j) { const int k = 4 * lane + 256 * j; xq[q][j] = *(const u32x2*)(xr + k); gg[q][j] = *(const f32x4*)(g2 + k); ya[q][j] = *(const u32x2*)(y0 + k); yb[q][j] = *(const u32x2*)(y1 + k); } }
#pragma unroll
        for (int q = 0; q < 2; ++q)
#pragma unroll
            for (int j = 0; j < 4; ++j) { const u32x2 a = ya[q][j], b = yb[q][j], xx = xq[q][j]; const f32x4 x = (f32x4){bflo(xx.x), bfhi(xx.x), bflo(xx.y), bfhi(xx.y)};
                f32x4 f; f.x = bflo(a.x) + bflo(b.x); f.y = bfhi(a.x) + bfhi(b.x); f.z = bflo(a.y) + bflo(b.y); f.w = bfhi(a.y) + bfhi(b.y);
                v[q][j] = x + gg[q][j] * f; }
#pragma unroll
        for (int q = 0; q < 2; ++q) if (q == 0 || rows[1] != rows[0]) { const int row = rows[q];
            if (!last) { bf16_t* xr = (bf16_t*)(X.ws + WS_XL) + (size_t)row * 1024;
#pragma unroll
                for (int j = 0; j < 4; ++j) { u32x2 w; w.x = pk2(v[q][j].x, v[q][j].y); w.y = pk2(v[q][j].z, v[q][j].w); *(u32x2*)(xr + 4 * lane + 256 * j) = w; }
                norm_mod_store(v[q], X.in(4) + (l + 1) * 1024, mod_vec(X, l + 1, row, 0), mod_vec(X, l + 1, row, 1), (bf16_t*)(X.ws + WS_H) + (size_t)row * 1024, lane);
            } else {
                float ss = 0.f;
#pragma unroll
                for (int j = 0; j < 4; ++j) ss += (v[q][j].x * v[q][j].x + v[q][j].y * v[q][j].y) + (v[q][j].z * v[q][j].z + v[q][j].w * v[q][j].w);
                const float rstd = 1.0f / sqrtf(wave_sum(ss, lane) * (1.0f / 1024.0f) + 1e-6f);
                float* orow = X.out + (size_t)(row - R_CTX) * 1024;
#pragma unroll
                for (int j = 0; j < 4; ++j) { const int k = 4 * lane + 256 * j; const f32x4 g4 = *(const f32x4*)(X.in(23) + k); *(f32x4*)(orow + k) = v[q][j] * rstd * g4; }
            } }
    }
}

DI void phase_route(const Ctx& X, int l, char* lds) {
    const int tid = X.tid, lane = tid & 63, wave = tid >> 6; const int gw = X.c * 8 + wave, NGW = X.G * 8;
    float* Wg = (float*)lds;
    float* We = (float*)(lds + 16384);
    { const float* wg = X.in(16) + (size_t)l * 1024 * 4; const float* we = X.in(18) + (size_t)l * 1024 * 32;
      for (int e = tid; e < 1024; e += 512) *(f32x4*)(Wg + 4 * e) = *(const f32x4*)(wg + 4 * e);
      for (int e = tid; e < 1024 * 8; e += 512) { const int k = e >> 3, o4 = e & 7; *(f32x4*)(We + ((o4 >> 1) * 1024 + k) * 8 + (o4 & 1) * 4) = *(const f32x4*)(we + k * 32 + o4 * 4); } }
    int* hist = (int*)(lds + 16384 + 131072);
    if (tid < 32) hist[tid] = 0;
    __syncthreads();
    const int row_lo = (l == DEPTH - 1) ? R_CTX : 0, rpb = (R_ALL - row_lo) / X.G;
    const float* gn = X.in(5) + l * 1024 + lane;
    int* toke = (int*)(X.ws + WS_ROUTE + RT_TOKE); float* tokw = (float*)(X.ws + WS_ROUTE + RT_TOKW);
    const int rpw = rpb / 8;
    for (int rr = 0; rr < rpw; rr += 2) {
        const int rowA = row_lo + X.c * rpb + wave * rpw + rr; const bool two = (rr + 1 < rpw); const int rowB = two ? rowA + 1 : rowA;
        float hv[2][16]; float scv[2][16], shv[2][16];
#pragma unroll
        for (int q = 0; q < 2; ++q) { const int row = q ? rowB : rowA; const bf16_t* xr = (const bf16_t*)(X.ws + WS_XL) + (size_t)row * 1024 + lane;
            const float* sh = mod_vec(X, l, row, 3) + lane; const float* sc = mod_vec(X, l, row, 4) + lane;
#pragma unroll
            for (int i = 0; i < 16; ++i) { hv[q][i] = bf2f(xr[64 * i]); scv[q][i] = sc[64 * i]; shv[q][i] = sh[64 * i]; } }
        float gl[16];
#pragma unroll
        for (int i = 0; i < 16; ++i) gl[i] = gn[64 * i];
        float ss[2] = {0.f, 0.f};
#pragma unroll
        for (int q = 0; q < 2; ++q)
#pragma unroll
            for (int i = 0; i < 16; ++i) ss[q] += hv[q][i] * hv[q][i];
#pragma unroll
        for (int q = 0; q < 2; ++q) { const float rstd = 1.0f / sqrtf(wave_sum(ss[q], lane) * (1.0f / 1024.0f) + 1e-6f);
            bf16_t* hrow = (bf16_t*)(X.ws + WS_H) + (size_t)(q ? rowB : rowA) * 1024 + lane;
#pragma unroll
            for (int i = 0; i < 16; ++i) { hv[q][i] = hv[q][i] * rstd * gl[i] * (1.0f + scv[q][i]) + shv[q][i]; hrow[64 * i] = f2bf(hv[q][i]); } }
        float lg[2][4];
#pragma unroll
        for (int q = 0; q < 2; ++q) { lg[q][0] = 0.f; lg[q][1] = 0.f; lg[q][2] = 0.f; lg[q][3] = 0.f; }
#pragma unroll
        for (int i = 0; i < 16; ++i) { const f32x4 w = *(const f32x4*)(Wg + (lane + 64 * i) * 4);
#pragma unroll
            for (int q = 0; q < 2; ++q) { lg[q][0] += hv[q][i] * w[0]; lg[q][1] += hv[q][i] * w[1]; lg[q][2] += hv[q][i] * w[2]; lg[q][3] += hv[q][i] * w[3]; } }
        int grp[2]; float pg[2];
#pragma unroll
        for (int q = 0; q < 2; ++q) {
#pragma unroll
            for (int o = 0; o < 4; ++o) lg[q][o] = wave_sum(lg[q][o], lane) + X.in(17)[l * 4 + o];
            int g = 0; float gm = lg[q][0];
#pragma unroll
            for (int o = 1; o < 4; ++o) if (lg[q][o] > gm) { gm = lg[q][o]; g = o; }
            grp[q] = __builtin_amdgcn_readfirstlane(g);
            float den = 0.f;
#pragma unroll
            for (int o = 0; o < 4; ++o) den += __expf(lg[q][o] - gm);
            pg[q] = 1.0f / den; }
        float le[2][8];
#pragma unroll
        for (int q = 0; q < 2; ++q) { const float* wp = We + (size_t)grp[q] * 8192 + lane * 8;
#pragma unroll
            for (int j = 0; j < 8; ++j) le[q][j] = 0.f;
#pragma unroll
            for (int i = 0; i < 16; ++i) { const f32x4 w0 = *(const f32x4*)(wp + i * 512), w1 = *(const f32x4*)(wp + i * 512 + 4);
                le[q][0] += hv[q][i] * w0[0]; le[q][1] += hv[q][i] * w0[1]; le[q][2] += hv[q][i] * w0[2]; le[q][3] += hv[q][i] * w0[3]; le[q][4] += hv[q][i] * w1[0]; le[q][5] += hv[q][i] * w1[1]; le[q][6] += hv[q][i] * w1[2]; le[q][7] += hv[q][i] * w1[3]; } }
#pragma unroll
        for (int q = 0; q < 2; ++q) {
#pragma unroll
            for (int j = 0; j < 8; ++j) le[q][j] = wave_sum(le[q][j], lane) + X.in(19)[l * 32 + grp[q] * 8 + j];
            int i0 = 0; float v0 = le[q][0];
#pragma unroll
            for (int j = 1; j < 8; ++j) if (le[q][j] > v0) { v0 = le[q][j]; i0 = j; }
            int i1 = -1; float v1 = -3.0e38f;
#pragma unroll
            for (int j = 0; j < 8; ++j) if (j != i0 && le[q][j] > v1) { v1 = le[q][j]; i1 = j; }
            const float w0 = pg[q] / (1.0f + __expf(v1 - v0)), w1 = pg[q] - w0;
            if (lane == 0 && (q == 0 || two)) { const int row = q ? rowB : rowA; const int e0 = grp[q] * 8 + i0, e1 = grp[q] * 8 + i1;
                toke[row * 2] = e0; toke[row * 2 + 1] = e1; tokw[row * 2] = w0; tokw[row * 2 + 1] = w1;
                atomicAdd(hist + e0, 1); atomicAdd(hist + e1, 1); }
        }
    }
    __syncthreads();
    if (tid < 32) ((unsigned*)(X.ws + WS_CTL) + CW_BLK + l * 8192)[X.c * 32 + tid] = (unsigned)hist[tid];
}
DI void phase_sortcopy(const Ctx& X, int l, char* lds) {
    const int tid = X.tid, lane = tid & 63, wave = tid >> 6;
    LAS int* tb = (LAS int*)(LAS char*)(lds + LDS_TBL);
    build_expert_table(X, l, tb);
    const int* toke = (const int*)(X.ws + WS_ROUTE + RT_TOKE); const float* tokw = (const float*)(X.ws + WS_ROUTE + RT_TOKW);
    int* sdst = (int*)(X.ws + WS_ROUTE + RT_SDST); float* sw = (float*)(X.ws + WS_ROUTE + RT_SW);
    const int row_lo = (l == DEPTH - 1) ? R_CTX : 0, rpb = (R_ALL - row_lo) / X.G, rpw = rpb / 8;
    const int row0 = row_lo + X.c * rpb + wave * rpw;
    int slot = 0;
    if (lane < 2 * rpw) { const int e = toke[row0 * 2 + lane]; const float w = tokw[row0 * 2 + lane];
        slot = tb[128 + e] + __hip_atomic_fetch_add((LAS int*)(tb + 160 + e), 1, __ATOMIC_RELAXED, __HIP_MEMORY_SCOPE_WORKGROUP);
        sdst[slot] = row0 * 2 + lane; sw[slot] = w; ((int*)toke)[row0 * 2 + lane] = slot; }
}
#define MFMA32(a, b, c) __builtin_amdgcn_mfma_f32_32x32x16_bf16((a), (b), (c), 0, 0, 0)
DI int crow(int reg, int h) { return (reg & 3) + 8 * (reg >> 2) + 4 * h; }
constexpr float L2E = 1.4426950408889634f;
constexpr int KS_LD = 72, VT_LD = 132, ST_LD = 136;
constexpr int LDS_KS = 0, LDS_VT = 128 * KS_LD * 2, LDS_SL = LDS_VT + 64 * 136 * 2;
DI void unpack8(const u32x4 v, float (&f)[8]) { f[0] = bflo(v.x); f[1] = bfhi(v.x); f[2] = bflo(v.y); f[3] = bfhi(v.y); f[4] = bflo(v.z); f[5] = bfhi(v.z); f[6] = bflo(v.w); f[7] = bfhi(v.w); }
DI u32x4 pack8(const float (&f)[8]) { u32x4 o; o.x = pk2(f[0], f[1]); o.y = pk2(f[2], f[3]); o.z = pk2(f[4], f[5]); o.w = pk2(f[6], f[7]); return o; }
DI void rope8(u32x4& a, u32x4& b, const float* tc, const float* ts) {
    float x1[8], x2[8]; unpack8(a, x1); unpack8(b, x2);
    const f32x4 c0 = *(const f32x4*)tc, c1 = *(const f32x4*)(tc + 4), s0 = *(const f32x4*)ts, s1 = *(const f32x4*)(ts + 4);
    float o1[8], o2[8];
#pragma unroll
    for (int j = 0; j < 8; ++j) { const float c = j < 4 ? c0[j & 3] : c1[j & 3], s = j < 4 ? s0[j & 3] : s1[j & 3]; o1[j] = x1[j] * c - x2[j] * s; o2[j] = x1[j] * s + x2[j] * c; }
    a = pack8(o1); b = pack8(o2);
}
template <int LD = VT_LD>
DI void stage_vt(const bf16_t* proj, int row0, int col0, bf16_t* VT, int tid) {
#pragma unroll
    for (int i = 0; i < 2; ++i) { const int p = tid + 512 * i, key = p >> 3, c8 = p & 7;
        const u32x4 v = *(const u32x4*)(PJ(proj, row0 + key, col0 + 8 * c8));
        bf16_t* d = VT + (8 * c8) * LD + key;
        d[0 * LD] = (bf16_t)(v.x & 0xffff); d[1 * LD] = (bf16_t)(v.x >> 16); d[2 * LD] = (bf16_t)(v.y & 0xffff); d[3 * LD] = (bf16_t)(v.y >> 16);
        d[4 * LD] = (bf16_t)(v.z & 0xffff); d[5 * LD] = (bf16_t)(v.z >> 16); d[6 * LD] = (bf16_t)(v.w & 0xffff); d[7 * LD] = (bf16_t)(v.w >> 16); }
}
DI bf16x8 vt_frag(const bf16_t* VT, int dvrow, int kbase, int h) {
    const u32x2 lo = *(const u32x2*)(VT + dvrow * VT_LD + kbase + 4 * h), hi = *(const u32x2*)(VT + dvrow * VT_LD + kbase + 8 + 4 * h);
    u32x4 w; w.x = lo.x; w.y = lo.y; w.z = hi.x; w.w = hi.y; return __builtin_bit_cast(bf16x8, w);
}

DI void attn_unit(const Ctx& X, int l, char* lds, bool is_ctx, int b, int kvh, int qblk) {
    const int tid = X.tid, lane = tid & 63, wave = __builtin_amdgcn_readfirstlane(tid >> 6), r = lane & 31, h = lane >> 5;
    const int g = wave >> 1, qh = wave & 1, head = kvh * 4 + g;
    const bf16_t* proj = (const bf16_t*)(X.ws + WS_PROJ); const float* tab = (const float*)(X.ws + WS_TAB);
    bf16_t* Ks = (bf16_t*)(lds + LDS_KS); bf16_t* VT = (bf16_t*)(lds + LDS_VT);
    const int qrow0 = is_ctx ? b * 256 + qblk * 128 : R_CTX + b * 2048 + qblk * 128;
    bf16x8 qf[2][4];
#pragma unroll
    for (int qt = 0; qt < 2; ++qt) { const int i = qh * 64 + qt * 32 + r; const bf16_t* qp = PJ(proj, qrow0 + i, PC_QA + head * 64 + 8 * h);
        u32x4 f0 = *(const u32x4*)(qp), f1 = *(const u32x4*)(qp + 16), f2 = *(const u32x4*)(qp + 32), f3 = *(const u32x4*)(qp + 48);
        if (!is_ctx) { const int n = qblk * 128 + i, prow = n >> 6, pcol = n & 63;
            rope8(f0, f1, tab + TB_ROWC + prow * 16 + 8 * h, tab + TB_ROWS + prow * 16 + 8 * h);
            rope8(f2, f3, tab + TB_COLC + pcol * 16 + 8 * h, tab + TB_COLS + pcol * 16 + 8 * h); }
        qf[qt][0] = __builtin_bit_cast(bf16x8, f0); qf[qt][1] = __builtin_bit_cast(bf16x8, f1); qf[qt][2] = __builtin_bit_cast(bf16x8, f2); qf[qt][3] = __builtin_bit_cast(bf16x8, f3); }
    f32x16 O[2][2]; float mrun[2], lsum[2];
#pragma unroll
    for (int qt = 0; qt < 2; ++qt) { mrun[qt] = -1e30f; lsum[qt] = 0.f;
#pragma unroll
        for (int dv = 0; dv < 2; ++dv)
#pragma unroll
            for (int e = 0; e < 16; ++e) O[qt][dv][e] = 0.f; }
    const int nchunk = is_ctx ? 2 : 5;
    u32x4 pka, pkb, pva[2];
    const int skey = tid >> 2, scc = tid & 3, sc = (scc & 1) + 4 * (scc >> 1);
#define ATT_CHUNK(ci_, krow0_, rel_, kblk_, ok_) do { if ((ci_) < 2) { krow0_ = b * 256 + (ci_) * 128; rel_ = 0; kblk_ = 0; ok_ = true; } \
        else { rel_ = (ci_) - 3; kblk_ = qblk + rel_; ok_ = (kblk_ >= 0 && kblk_ < 16); krow0_ = R_CTX + b * 2048 + kblk_ * 128; } } while (0)
#define ATT_ISSUE(ci_) do { int kr_, rl_, kb_; bool ok_; ATT_CHUNK(ci_, kr_, rl_, kb_, ok_); if (ok_) { \
        const bf16_t* kp_ = PJ(proj, kr_ + skey, PC_KA + kvh * 64 + 8 * sc); pka = *(const u32x4*)kp_; pkb = *(const u32x4*)(kp_ + 16); \
        _Pragma("unroll") for (int q_ = 0; q_ < 2; ++q_) { const int p_ = tid + 512 * q_; pva[q_] = *(const u32x4*)(PJ(proj, kr_ + (p_ >> 3), PC_VA + kvh * 64 + 8 * (p_ & 7))); } } } while (0)
    ATT_ISSUE(0);
    for (int ci = 0; ci < nchunk; ++ci) {
        int krow0, rel, kblk; bool okc; ATT_CHUNK(ci, krow0, rel, kblk, okc);
        if (!okc) { continue; }
        __syncthreads();
        { u32x4 a = pka, bq = pkb;
          if (ci >= 2) { const int n = kblk * 128 + skey; const int pos = (sc < 2) ? (n >> 6) : (n & 63);
              rope8(a, bq, tab + ((sc < 2) ? TB_ROWC : TB_COLC) + pos * 16 + 8 * (sc & 1), tab + ((sc < 2) ? TB_ROWS : TB_COLS) + pos * 16 + 8 * (sc & 1)); }
          *(u32x4*)(Ks + skey * KS_LD + 8 * sc) = a; *(u32x4*)(Ks + skey * KS_LD + 8 * sc + 16) = bq;
#pragma unroll
          for (int q = 0; q < 2; ++q) { const int p = tid + 512 * q, key = p >> 3, c8 = p & 7; const u32x4 v = pva[q]; bf16_t* d = VT + (8 * c8) * VT_LD + key;
              d[0 * VT_LD] = (bf16_t)(v.x & 0xffff); d[1 * VT_LD] = (bf16_t)(v.x >> 16); d[2 * VT_LD] = (bf16_t)(v.y & 0xffff); d[3 * VT_LD] = (bf16_t)(v.y >> 16);
              d[4 * VT_LD] = (bf16_t)(v.z & 0xffff); d[5 * VT_LD] = (bf16_t)(v.z >> 16); d[6 * VT_LD] = (bf16_t)(v.w & 0xffff); d[7 * VT_LD] = (bf16_t)(v.w >> 16); } }
        __syncthreads();
        { int nx = ci + 1; if (nx < nchunk) { int kr2, rl2, kb2; bool ok2; ATT_CHUNK(nx, kr2, rl2, kb2, ok2); if (!ok2) nx = nx + 1; } if (nx < nchunk) { ATT_ISSUE(nx); } }
#pragma unroll 1
        for (int kt = 0; kt < 4; ++kt) {
            if ((rel < 0 && qh == 1 && kt < 2) || (rel > 0 && qh == 0 && kt >= 2)) continue;
            f32x16 st[2];
#pragma unroll
            for (int e = 0; e < 16; ++e) { st[0][e] = 0.f; st[1][e] = 0.f; }
            bf16x8 kf[4];
#pragma unroll
            for (int s = 0; s < 4; ++s) kf[s] = *(const bf16x8*)(Ks + (kt * 32 + r) * KS_LD + 16 * s + 8 * h);
#pragma unroll
            for (int s = 0; s < 4; ++s) { st[0] = MFMA32(kf[s], qf[0][s], st[0]); st[1] = MFMA32(kf[s], qf[1][s], st[1]); }
            bf16x8 vfr[2][2];
#pragma unroll
            for (int dv = 0; dv < 2; ++dv)
#pragma unroll
                for (int s2 = 0; s2 < 2; ++s2) vfr[dv][s2] = vt_frag(VT, dv * 32 + r, kt * 32 + 16 * s2, h);
            bf16x8 pb[2][2];
#pragma unroll
            for (int qt = 0; qt < 2; ++qt) {
                const int i = qh * 64 + qt * 32 + r;
                if (rel != 0) {
#pragma unroll
                    for (int e = 0; e < 16; ++e) { const int jj = kt * 32 + crow(e, h); const bool ok = (rel < 0) ? (jj >= i) : (jj <= i); st[qt][e] = ok ? st[qt][e] : -1e30f; } }
                float tmax = st[qt][0];
#pragma unroll
                for (int e = 1; e < 16; ++e) tmax = fmaxf(tmax, st[qt][e]);
                tmax = fmaxf(tmax, shx(tmax, 32, lane));
                const float mnew = fmaxf(mrun[qt], tmax), mb = mnew * L2E;
                if (__any(mnew != mrun[qt])) {
                    const float alpha = fast_exp2((mrun[qt] - mnew) * L2E); lsum[qt] *= alpha;
#pragma unroll
                    for (int dv = 0; dv < 2; ++dv)
#pragma unroll
                        for (int e = 0; e < 16; ++e) O[qt][dv][e] *= alpha; }
                mrun[qt] = mnew;
                float ps = 0.f; float p[16];
#pragma unroll
                for (int e = 0; e < 16; ++e) { p[e] = fast_exp2(st[qt][e] * L2E - mb); ps += p[e]; }
                lsum[qt] += ps;
                u32x4 w0, w1; w0.x = pk2(p[0], p[1]); w0.y = pk2(p[2], p[3]); w0.z = pk2(p[4], p[5]); w0.w = pk2(p[6], p[7]); w1.x = pk2(p[8], p[9]); w1.y = pk2(p[10], p[11]); w1.z = pk2(p[12], p[13]); w1.w = pk2(p[14], p[15]);
                pb[qt][0] = __builtin_bit_cast(bf16x8, w0); pb[qt][1] = __builtin_bit_cast(bf16x8, w1);
            }
#pragma unroll
            for (int dv = 0; dv < 2; ++dv)
#pragma unroll
                for (int s2 = 0; s2 < 2; ++s2) { O[0][dv] = MFMA32(vfr[dv][s2], pb[0][s2], O[0][dv]); O[1][dv] = MFMA32(vfr[dv][s2], pb[1][s2], O[1][dv]); }
        }
    }
#undef ATT_CHUNK
#undef ATT_ISSUE
    const float sink = X.in(9)[l * 8 + head];
    bf16_t* oa = (bf16_t*)(X.ws + WS_OA);
#pragma unroll
    for (int qt = 0; qt < 2; ++qt) { float lt = lsum[qt]; lt += shx(lt, 32, lane); lt += fast_exp2((sink - mrun[qt]) * L2E); const float inv = 1.0f / lt;
        const int i = qh * 64 + qt * 32 + r; bf16_t* op = oa + (size_t)(qrow0 + i) * 512 + head * 64;
#pragma unroll
        for (int dv = 0; dv < 2; ++dv)
#pragma unroll
            for (int rg = 0; rg < 4; ++rg) { u32x2 w; w.x = pk2(O[qt][dv][4 * rg] * inv, O[qt][dv][4 * rg + 1] * inv); w.y = pk2(O[qt][dv][4 * rg + 2] * inv, O[qt][dv][4 * rg + 3] * inv);
                *(u32x2*)(op + dv * 32 + 8 * rg + 4 * h) = w; } }
}

DI void fourier_fold_rows(const Ctx& X, char* lds) {
    const int lane = X.tid & 63, wave = X.tid >> 6; const int gw = X.c * 8 + wave, NGW = X.G * 8;
    bf16_t* sr = (bf16_t*)(lds + wave * 8192);
    for (int row = gw; row < 8 * 512; row += NGW) {
        bf16_t* ut = (bf16_t*)(X.ws + WS_UT) + (size_t)row * 4096;
#pragma unroll
        for (int i = 0; i < 8; ++i) *(u32x4*)(sr + (i * 64 + lane) * 8) = *(const u32x4*)(ut + (i * 64 + lane) * 8);
        asm volatile("s_waitcnt vmcnt(0) lgkmcnt(0)" ::: "memory");
#pragma unroll
        for (int i = 0; i < 4; ++i) { const int j0 = (i * 64 + lane) * 8; float v[8];
#pragma unroll
            for (int t = 0; t < 8; ++t) { const int j = j0 + t; float x;
                if (j == 0 || j == 1024) x = bf2f(sr[j]);
                else if (j < 1024) x = bf2f(sr[j]) + bf2f(sr[2048 - j]);
                else { const int n = j - 1024; x = bf2f(sr[2048 + n]) - bf2f(sr[4096 - n]); }
                v[t] = x; }
            *(u32x4*)(ut + j0) = pack8(v); }
        asm volatile("s_waitcnt lgkmcnt(0)" ::: "memory");
    }
}
DI int ret_row0(int b, int c) { return c < 2 ? b * 256 + c * 128 : R_CTX + b * 2048 + (c - 2) * 128; }
DI void stage_ret_k(const Ctx& X, const bf16_t* proj, int b, int hh, int c, bf16_t* Ks, int tid) {
    const float* tab = (const float*)(X.ws + WS_TAB);
    const int pos = tid >> 2, cc = tid & 3; const bf16_t* kp = PJ(proj, ret_row0(b, c) + pos, PC_KR + hh * 64 + 8 * cc);
    u32x4 a = *(const u32x4*)kp, bq = *(const u32x4*)(kp + 32);
    if (c >= 2) { const int n = (c - 2) * 128 + pos; rope8(a, bq, tab + TB_RETC + n * 32 + 8 * cc, tab + TB_RETS + n * 32 + 8 * cc); }
    *(u32x4*)(Ks + pos * KS_LD + 8 * cc) = a; *(u32x4*)(Ks + pos * KS_LD + 32 + 8 * cc) = bq;
}
struct StLoads { u32x4 a, bq, va[2]; f32x4 c0, c1, s0, s1; };
DI void st_issue(const Ctx& X, StLoads& L, int b, int hh, int c) {
    const int tid = X.tid; const bf16_t* proj = (const bf16_t*)(X.ws + WS_PROJ); const float* tab = (const float*)(X.ws + WS_TAB);
    const int pos = tid >> 2, cc = tid & 3, row0 = ret_row0(b, c); const bf16_t* kp = PJ(proj, row0 + pos, PC_KR + hh * 64 + 8 * cc);
    L.a = *(const u32x4*)kp; L.bq = *(const u32x4*)(kp + 32);
    const int n = (c >= 2) ? (c - 2) * 128 + pos : 0; const float* tc = tab + TB_RETC + n * 32 + 8 * cc; const float* ts = tab + TB_RETS + n * 32 + 8 * cc;
    L.c0 = *(const f32x4*)tc; L.c1 = *(const f32x4*)(tc + 4); L.s0 = *(const f32x4*)ts; L.s1 = *(const f32x4*)(ts + 4);
#pragma unroll
    for (int q = 0; q < 2; ++q) { const int p = tid + 512 * q, key = p >> 3, c8 = p & 7; L.va[q] = *(const u32x4*)(PJ(proj, row0 + key, PC_VR + hh * 64 + 8 * c8)); }
}
DI void ret_state_range(const Ctx& X, int l, char* lds, int u0, int ustride, int ulimit) {
    if (u0 >= ulimit) return;
    const int tid = X.tid, lane = tid & 63, wave = __builtin_amdgcn_readfirstlane(tid >> 6), r = lane & 31, h = lane >> 5;
    const float* tab = (const float*)(X.ws + WS_TAB);
    bf16_t* kfT = (bf16_t*)lds; bf16_t* kbT = kfT + 64 * ST_LD; bf16_t* vT = kbT + 64 * ST_LD;
    StLoads L; st_issue(X, L, u0 / 144, (u0 / 18) & 7, u0 % 18);
#pragma unroll 1
    for (int u = u0; u < ulimit; u += ustride) {
        const int b = u / 144, hh = (u / 18) & 7, c = u % 18;
        const float lgf = tab[TB_LG + l * 16 + hh], lgb = tab[TB_LG + l * 16 + 8 + hh];
        __syncthreads();
        { const int pos = tid >> 2, cc = tid & 3; float k1[8], k2[8]; unpack8(L.a, k1); unpack8(L.bq, k2);
          if (c >= 2) {
#pragma unroll
              for (int j = 0; j < 8; ++j) { const float cv = j < 4 ? L.c0[j & 3] : L.c1[j & 3], sv = j < 4 ? L.s0[j & 3] : L.s1[j & 3]; const float x1 = bf2f(f2bf(k1[j] * cv - k2[j] * sv)), x2 = bf2f(f2bf(k1[j] * sv + k2[j] * cv)); k1[j] = x1; k2[j] = x2; } }
          const float zf = fast_exp2((float)(127 - pos) * lgf), zb = fast_exp2((float)pos * lgb);
#pragma unroll
          for (int j = 0; j < 8; ++j) { kfT[(8 * cc + j) * ST_LD + pos] = f2bf(k1[j] * zf); kfT[(32 + 8 * cc + j) * ST_LD + pos] = f2bf(k2[j] * zf);
              kbT[(8 * cc + j) * ST_LD + pos] = f2bf(k1[j] * zb); kbT[(32 + 8 * cc + j) * ST_LD + pos] = f2bf(k2[j] * zb); }
#pragma unroll
          for (int q = 0; q < 2; ++q) { const int p = tid + 512 * q, key = p >> 3, c8 = p & 7; const u32x4 v = L.va[q]; bf16_t* d = vT + (8 * c8) * ST_LD + key;
              d[0 * ST_LD] = (bf16_t)(v.x & 0xffff); d[1 * ST_LD] = (bf16_t)(v.x >> 16); d[2 * ST_LD] = (bf16_t)(v.y & 0xffff); d[3 * ST_LD] = (bf16_t)(v.y >> 16);
              d[4 * ST_LD] = (bf16_t)(v.z & 0xffff); d[5 * ST_LD] = (bf16_t)(v.z >> 16); d[6 * ST_LD] = (bf16_t)(v.w & 0xffff); d[7 * ST_LD] = (bf16_t)(v.w >> 16); } }
        __syncthreads();
        if (u + ustride < ulimit) { const int u2 = u + ustride; st_issue(X, L, u2 / 144, (u2 / 18) & 7, u2 % 18); }
        const int dir = wave >> 2, dvt = (wave >> 1) & 1, dkt = wave & 1; const bf16_t* kT = dir ? kbT : kfT;
        f32x16 acc;
#pragma unroll
        for (int e = 0; e < 16; ++e) acc[e] = 0.f;
#pragma unroll
        for (int s = 0; s < 8; ++s) { const bf16x8 a = *(const bf16x8*)(vT + (dvt * 32 + r) * ST_LD + 16 * s + 8 * h), bb = *(const bf16x8*)(kT + (dkt * 32 + r) * ST_LD + 16 * s + 8 * h); acc = MFMA32(a, bb, acc); }
        float* U = (float*)(X.ws + WS_H) + ((size_t)(((b * 8 + hh) * 18 + c) * 2 + dir)) * 4096;
#pragma unroll
        for (int e = 0; e < 16; ++e) U[(dvt * 32 + crow(e, h)) * 64 + dkt * 32 + r] = acc[e];
    }
}
DI void ret_scan_unit(const Ctx& X, int l, int b, int hh) {
    const int tid = X.tid; const float* tab = (const float*)(X.ws + WS_TAB);
    const float g128f = fast_exp2(128.0f * tab[TB_LG + l * 16 + hh]), g128b = fast_exp2(128.0f * tab[TB_LG + l * 16 + 8 + hh]);
    const float* U = (const float*)(X.ws + WS_H) + (size_t)(b * 8 + hh) * 36 * 4096; bf16_t* S = (bf16_t*)(X.ws + WS_SST) + (size_t)(b * 8 + hh) * 36 * 4096;
    const int e0 = tid * 8;
#define UL(c, dir, j) U[((c) * 2 + (dir)) * 4096 + e0 + (j)]
#define SS(c, dir) (S + ((c) * 2 + (dir)) * 4096 + e0)
    float st[8], z[8];
#pragma unroll
    for (int j = 0; j < 8; ++j) z[j] = 0.f;
#pragma unroll
    for (int j = 0; j < 8; ++j) st[j] = UL(0, 0, j);
    { u32x4 zz = {0u, 0u, 0u, 0u}; asm volatile("" : "+v"(zz)); *(u32x4*)SS(0, 0) = zz; } *(u32x4*)SS(1, 0) = pack8(st);
#pragma unroll
    for (int j = 0; j < 8; ++j) st[j] = g128f * st[j] + UL(1, 0, j);
    for (int c = 2; c < 18; ++c) { *(u32x4*)SS(c, 0) = pack8(st);
#pragma unroll
        for (int j = 0; j < 8; ++j) st[j] = g128f * st[j] + UL(c, 0, j); }
#pragma unroll
    for (int j = 0; j < 8; ++j) st[j] = UL(1, 1, j);
    { u32x4 zz = {0u, 0u, 0u, 0u}; asm volatile("" : "+v"(zz)); *(u32x4*)SS(1, 1) = zz; } *(u32x4*)SS(0, 1) = pack8(st);
#pragma unroll
    for (int j = 0; j < 8; ++j) st[j] = UL(0, 1, j) + g128b * st[j];
    for (int c = 17; c >= 2; --c) { *(u32x4*)SS(c, 1) = pack8(st);
#pragma unroll
        for (int j = 0; j < 8; ++j) st[j] = g128b * st[j] + UL(c, 1, j); }
#undef UL
#undef SS
}
DI unsigned* ret_flag(const Ctx& X, int l, int b, int hh) { return (unsigned*)(X.ws + WS_CTL) + CW_FLAG + ((l * 64 + b * 8 + hh) * 64); }
DI void ret_scan_publish(const Ctx& X, int l, int b, int hh) {
    asm volatile("s_waitcnt vmcnt(0)" ::: "memory");
    __syncthreads();
    if (X.tid == 0) { __builtin_amdgcn_fence(__ATOMIC_RELEASE, "agent"); asm volatile("s_waitcnt vmcnt(0)" ::: "memory");
        __hip_atomic_store(ret_flag(X, l, b, hh), 1u, __ATOMIC_RELAXED, __HIP_MEMORY_SCOPE_AGENT); }
}
DI void ret_scan_wait_all(const Ctx& X, int l) {
    if (X.tid < 64) { unsigned* f = ret_flag(X, l, X.tid >> 3, X.tid & 7); unsigned sp = 0;
        while (__hip_atomic_load(f, __ATOMIC_RELAXED, __HIP_MEMORY_SCOPE_AGENT) == 0u) { __builtin_amdgcn_s_sleep(2); if (++sp > (1u << 22)) break; }
        __builtin_amdgcn_fence(__ATOMIC_ACQUIRE, "agent"); asm volatile("s_waitcnt vmcnt(0)" ::: "memory"); }
    __syncthreads();
}
struct RoLoads { u32x4 ka, kb2, va[2]; f32x4 kc0, kc1, ks0, ks1; u32x4 sst[2]; u32x4 f0, f1, f2, f3; };
DI void ro_issue(const Ctx& X, RoLoads& L, int b, int hh, int c) {
    const int tid = X.tid, lane = tid & 63, wave = tid >> 6, r = lane & 31, h = lane >> 5;
    const bf16_t* proj = (const bf16_t*)(X.ws + WS_PROJ); const float* tab = (const float*)(X.ws + WS_TAB);
    const int row0 = ret_row0(b, c), i = (wave & 3) * 32 + r;
    { const int pos = tid >> 2, cc = tid & 3; const bf16_t* kp = PJ(proj, row0 + pos, PC_KR + hh * 64 + 8 * cc); L.ka = *(const u32x4*)kp; L.kb2 = *(const u32x4*)(kp + 32);
      const int n = (c >= 2) ? (c - 2) * 128 + pos : 0; const float* tc = tab + TB_RETC + n * 32 + 8 * cc; const float* ts = tab + TB_RETS + n * 32 + 8 * cc;
      L.kc0 = *(const f32x4*)tc; L.kc1 = *(const f32x4*)(tc + 4); L.ks0 = *(const f32x4*)ts; L.ks1 = *(const f32x4*)(ts + 4);
#pragma unroll
      for (int q = 0; q < 2; ++q) { const int p = tid + 512 * q, key = p >> 3, c8 = p & 7; L.va[q] = *(const u32x4*)(PJ(proj, row0 + key, PC_VR + hh * 64 + 8 * c8)); } }
    { const bf16_t* S = (const bf16_t*)(X.ws + WS_SST) + ((size_t)((b * 8 + hh) * 18 + c)) * 2 * 4096;
#pragma unroll
      for (int q = 0; q < 2; ++q) L.sst[q] = *(const u32x4*)(S + (size_t)(tid + 512 * q) * 8); }
    { const bf16_t* qp = PJ(proj, row0 + i, PC_QR + hh * 64 + 8 * h);
      L.f0 = *(const u32x4*)(qp); L.f1 = *(const u32x4*)(qp + 16); L.f2 = *(const u32x4*)(qp + 32); L.f3 = *(const u32x4*)(qp + 48); }
}
DI void ret_out_range(const Ctx& X, int l, char* lds, int u0, int ustride, int ucount, int nc, int c0) {
    if (ucount <= 0) return;
    const int tid = X.tid, lane = tid & 63, wave = __builtin_amdgcn_readfirstlane(tid >> 6), r = lane & 31, h = lane >> 5;
    const bf16_t* proj = (const bf16_t*)(X.ws + WS_PROJ); const float* tab = (const float*)(X.ws + WS_TAB);
    bf16_t* Ks = (bf16_t*)(lds + LDS_KS); bf16_t* VT = (bf16_t*)(lds + LDS_VT); bf16_t* SL = (bf16_t*)(lds + LDS_SL);
    const int i = (wave & 3) * 32 + r;
    RoLoads L;
    ro_issue(X, L, (u0 / nc) >> 3, (u0 / nc) & 7, c0 + u0 % nc);
#pragma unroll 1
    for (int k = 0; k < ucount; ++k) {
        const int u = u0 + k * ustride, b = (u / nc) >> 3, hh = (u / nc) & 7, c = c0 + u % nc;
        const float lgf = tab[TB_LG + l * 16 + hh], lgb = tab[TB_LG + l * 16 + 8 + hh];
        const int row0 = ret_row0(b, c);
        u32x2 gg[2][4]; f32x4 qc[4], qs[4];
        { const int n = (c >= 2) ? (c - 2) * 128 + i : 0; const float* tc = tab + TB_RETC + n * 32 + 8 * h; const float* ts = tab + TB_RETS + n * 32 + 8 * h;
          qc[0] = *(const f32x4*)tc; qc[1] = *(const f32x4*)(tc + 4); qc[2] = *(const f32x4*)(tc + 16); qc[3] = *(const f32x4*)(tc + 20);
          qs[0] = *(const f32x4*)ts; qs[1] = *(const f32x4*)(ts + 4); qs[2] = *(const f32x4*)(ts + 16); qs[3] = *(const f32x4*)(ts + 20); }
        if (wave < 4) { const bf16_t* gp = PJ(proj, row0 + i, PC_GR + hh * 64);
#pragma unroll
            for (int dv = 0; dv < 2; ++dv)
#pragma unroll
                for (int rg = 0; rg < 4; ++rg) gg[dv][rg] = *(const u32x2*)(gp + dv * 32 + 8 * rg + 4 * h); }
        __syncthreads();
        { const int pos = tid >> 2, cc = tid & 3; u32x4 ka = L.ka, kb2 = L.kb2;
          if (c >= 2) { float x1[8], x2[8], o1[8], o2[8]; unpack8(ka, x1); unpack8(kb2, x2);
#pragma unroll
              for (int j = 0; j < 8; ++j) { const float cv = j < 4 ? L.kc0[j & 3] : L.kc1[j & 3], sv = j < 4 ? L.ks0[j & 3] : L.ks1[j & 3]; o1[j] = x1[j] * cv - x2[j] * sv; o2[j] = x1[j] * sv + x2[j] * cv; }
              ka = pack8(o1); kb2 = pack8(o2); }
          *(u32x4*)(Ks + pos * KS_LD + 8 * cc) = ka; *(u32x4*)(Ks + pos * KS_LD + 32 + 8 * cc) = kb2;
#pragma unroll
          for (int q = 0; q < 2; ++q) { const int p = tid + 512 * q, key = p >> 3, c8 = p & 7; const u32x4 v = L.va[q]; bf16_t* d = VT + (8 * c8) * VT_LD + key;
              d[0 * VT_LD] = (bf16_t)(v.x & 0xffff); d[1 * VT_LD] = (bf16_t)(v.x >> 16); d[2 * VT_LD] = (bf16_t)(v.y & 0xffff); d[3 * VT_LD] = (bf16_t)(v.y >> 16);
              d[4 * VT_LD] = (bf16_t)(v.z & 0xffff); d[5 * VT_LD] = (bf16_t)(v.z >> 16); d[6 * VT_LD] = (bf16_t)(v.w & 0xffff); d[7 * VT_LD] = (bf16_t)(v.w >> 16); }
#pragma unroll
          for (int q = 0; q < 2; ++q) { const int e = tid + 512 * q, rowi = e >> 3, ch = e & 7; *(u32x4*)(SL + rowi * KS_LD + 8 * ch) = L.sst[q]; } }
        bf16x8 qf[4];
        { u32x4 f0 = L.f0, f1 = L.f1, f2 = L.f2, f3 = L.f3;
          if (c >= 2) { float x1[8], x2[8], o1[8], o2[8];
              unpack8(f0, x1); unpack8(f2, x2);
#pragma unroll
              for (int j = 0; j < 8; ++j) { const float cv = j < 4 ? qc[0][j & 3] : qc[1][j & 3], sv = j < 4 ? qs[0][j & 3] : qs[1][j & 3]; o1[j] = x1[j] * cv - x2[j] * sv; o2[j] = x1[j] * sv + x2[j] * cv; }
              f0 = pack8(o1); f2 = pack8(o2);
              unpack8(f1, x1); unpack8(f3, x2);
#pragma unroll
              for (int j = 0; j < 8; ++j) { const float cv = j < 4 ? qc[2][j & 3] : qc[3][j & 3], sv = j < 4 ? qs[2][j & 3] : qs[3][j & 3]; o1[j] = x1[j] * cv - x2[j] * sv; o2[j] = x1[j] * sv + x2[j] * cv; }
              f1 = pack8(o1); f3 = pack8(o2); }
          qf[0] = __builtin_bit_cast(bf16x8, f0); qf[1] = __builtin_bit_cast(bf16x8, f1); qf[2] = __builtin_bit_cast(bf16x8, f2); qf[3] = __builtin_bit_cast(bf16x8, f3); }
        __syncthreads();
        if (k + 1 < ucount) { const int u2 = u + ustride; ro_issue(X, L, (u2 / nc) >> 3, (u2 / nc) & 7, c0 + u2 % nc); }
        if (wave < 4) {
            f32x16 O[2];
#pragma unroll
            for (int dv = 0; dv < 2; ++dv)
#pragma unroll
                for (int e = 0; e < 16; ++e) O[dv][e] = 0.f;
#pragma unroll 1
            for (int kt = 0; kt < 4; ++kt) {
                f32x16 st;
#pragma unroll
                for (int e = 0; e < 16; ++e) st[e] = 0.f;
#pragma unroll
                for (int s = 0; s < 4; ++s) st = MFMA32(*(const bf16x8*)(Ks + (kt * 32 + r) * KS_LD + 16 * s + 8 * h), qf[s], st);
                float p[16];
#pragma unroll
                for (int e = 0; e < 16; ++e) { const int d = i - (kt * 32 + crow(e, h)); p[e] = st[e] * (d >= 0 ? fast_exp2((float)d * lgf) : fast_exp2((float)(-d) * lgb)); }
                u32x4 w0, w1; w0.x = pk2(p[0], p[1]); w0.y = pk2(p[2], p[3]); w0.z = pk2(p[4], p[5]); w0.w = pk2(p[6], p[7]); w1.x = pk2(p[8], p[9]); w1.y = pk2(p[10], p[11]); w1.z = pk2(p[12], p[13]); w1.w = pk2(p[14], p[15]);
                const bf16x8 pb0 = __builtin_bit_cast(bf16x8, w0), pb1 = __builtin_bit_cast(bf16x8, w1);
#pragma unroll
                for (int dv = 0; dv < 2; ++dv) { O[dv] = MFMA32(vt_frag(VT, dv * 32 + r, kt * 32, h), pb0, O[dv]); O[dv] = MFMA32(vt_frag(VT, dv * 32 + r, kt * 32 + 16, h), pb1, O[dv]); }
            }
            const float xif = fast_exp2((float)(i + 1) * lgf), xib = fast_exp2((float)(128 - i) * lgb);
#pragma unroll
            for (int dv = 0; dv < 2; ++dv) { f32x16 cf, cb;
#pragma unroll
                for (int e = 0; e < 16; ++e) { cf[e] = 0.f; cb[e] = 0.f; }
#pragma unroll
                for (int s = 0; s < 4; ++s) { cf = MFMA32(*(const bf16x8*)(SL + (dv * 32 + r) * KS_LD + 16 * s + 8 * h), qf[s], cf); cb = MFMA32(*(const bf16x8*)(SL + (64 + dv * 32 + r) * KS_LD + 16 * s + 8 * h), qf[s], cb); }
#pragma unroll
                for (int e = 0; e < 16; ++e) O[dv][e] += xif * cf[e] + xib * cb[e]; }
            float sm = 0.f;
#pragma unroll
            for (int dv = 0; dv < 2; ++dv)
#pragma unroll
                for (int e = 0; e < 16; ++e) sm += O[dv][e];
            sm += shx(sm, 32, lane); const float mu = sm * (1.0f / 64.0f);
            float sq = 0.f;
#pragma unroll
            for (int dv = 0; dv < 2; ++dv)
#pragma unroll
                for (int e = 0; e < 16; ++e) { const float d = O[dv][e] - mu; sq += d * d; }
            sq += shx(sq, 32, lane); const float rs = 1.0f / sqrtf(sq * (1.0f / 64.0f) + 1e-5f);
            bf16_t* op = (bf16_t*)(X.ws + WS_RET) + (size_t)(row0 + i) * 512 + hh * 64;
#pragma unroll
            for (int dv = 0; dv < 2; ++dv)
#pragma unroll
                for (int rg = 0; rg < 4; ++rg) { const int d0 = dv * 32 + 8 * rg + 4 * h; const u32x2 g2 = gg[dv][rg];
                    const float o0 = siluf_(bflo(g2.x)) * (O[dv][4 * rg] - mu) * rs, o1 = siluf_(bfhi(g2.x)) * (O[dv][4 * rg + 1] - mu) * rs, o2 = siluf_(bflo(g2.y)) * (O[dv][4 * rg + 2] - mu) * rs, o3 = siluf_(bfhi(g2.y)) * (O[dv][4 * rg + 3] - mu) * rs;
                    u32x2 w; w.x = pk2(o0, o1); w.y = pk2(o2, o3); *(u32x2*)(op + d0) = w; }
        }
    }
}
#define XB_TMO      128
#define XB_XCNT(j)  (256  + 64 * (j))
#define XB_XSUB(j)  (1280 + 64 * (j))
#define XB_XGEN(j)  (2304 + 64 * (j))
#define XB_TOP      3328
#define XB_TOPGEN   3392
#define XCD_BAR_WORDS 3456
#define XB_SPIN_CAP (1u << 18)
DI unsigned xb_ld(unsigned* p)              { return __hip_atomic_load(p, __ATOMIC_RELAXED, __HIP_MEMORY_SCOPE_AGENT); }
DI unsigned xb_add(unsigned* p, unsigned v) { return __hip_atomic_fetch_add(p, v, __ATOMIC_RELAXED, __HIP_MEMORY_SCOPE_AGENT); }
DI unsigned xb_xcc_id() { return (unsigned)__builtin_amdgcn_s_getreg((3 << 11) | 20) & 0xFu; }
#define XB_SPIN(cond, bar) do { unsigned _sp = 0; while (cond) { __builtin_amdgcn_s_sleep(1); \
    if ((++_sp & 255u) == 0u) { if (xb_ld(&(bar)[XB_TMO])) break; if (_sp > XB_SPIN_CAP) { atomicAdd(&(bar)[XB_TMO], 1u); break; } } } } while (0)
struct XcdBarrier { unsigned* bar; unsigned x; volatile LAS unsigned* st; };
DI XcdBarrier xcd_barrier_post(unsigned* bar, volatile LAS unsigned* st) {
    XcdBarrier b; b.bar = bar; b.x = xb_xcc_id(); b.st = st;
    if (threadIdx.x == 0) (void)xb_add(&bar[XB_XCNT(b.x)], 1u);
    return b;
}
DI void xcd_barrier_complete(unsigned* bar, unsigned x, unsigned& nloc, unsigned& nx) {
    const unsigned G = gridDim.x * gridDim.y * gridDim.z;
    unsigned sum, cnt, mine, sp = 0u;
    for (;;) {
        sum = 0u; cnt = 0u; mine = 0u;
#pragma unroll
        for (unsigned j = 0; j < 16; ++j) { const unsigned c = xb_ld(&bar[XB_XCNT(j)]); sum += c; cnt += (c > 0u) ? 1u : 0u; mine = (j == x) ? c : mine; }
        if (sum == G) break;
        __builtin_amdgcn_s_sleep(1);
        if ((++sp & 255u) == 0u) { if (xb_ld(&bar[XB_TMO])) break; if (sp > XB_SPIN_CAP) { atomicAdd(&bar[XB_TMO], 1u); break; } }
    }
    nloc = mine > 0u ? mine : 1u; nx = cnt > 0u ? cnt : 1u;
}
DI void xcd_barrier(const XcdBarrier& b, const int tid) {
    asm volatile("s_waitcnt vmcnt(0)" ::: "memory");
    __syncthreads();
    if (tid == 0) {
        unsigned* bar = b.bar;
        __builtin_amdgcn_s_waitcnt(0);
        unsigned nloc = b.st[0], nx = b.st[1];
        if (nloc == 0u) { xcd_barrier_complete(bar, b.x, nloc, nx); b.st[0] = nloc; b.st[1] = nx; }
        const unsigned old = xb_add(&bar[XB_XSUB(b.x)], 1u);
        const unsigned gen = old / nloc;
        if (old + 1u == (gen + 1u) * nloc) {
            __builtin_amdgcn_fence(__ATOMIC_RELEASE, "agent");
            asm volatile("s_waitcnt vmcnt(0)" ::: "memory");
            const unsigned og = xb_add(&bar[XB_TOP], 1u);
            const unsigned tg = og / nx;
            if (og + 1u == (tg + 1u) * nx) xb_add(&bar[XB_TOPGEN], 1u);
            else XB_SPIN(xb_ld(&bar[XB_TOPGEN]) == tg, bar);
            __builtin_amdgcn_fence(__ATOMIC_ACQUIRE, "agent");
            xb_add(&bar[XB_XGEN(b.x)], 1u);
            asm volatile("s_waitcnt vmcnt(0)" ::: "memory");
        } else {
            XB_SPIN(xb_ld(&bar[XB_XGEN(b.x)]) == gen, bar);
            __builtin_amdgcn_fence(__ATOMIC_ACQUIRE, "agent");
            asm volatile("s_waitcnt vmcnt(0)" ::: "memory");
        }
    }
    __syncthreads();
}
constexpr int N_PHASES = 20;

DI void run_phase(const Ctx& X, int ph, unsigned char* lds_raw) {
    char* lds = (char*)lds_raw; LAS unsigned char* ldsL = (LAS unsigned char*)lds_raw;
#ifndef ONLY
#define ONLY -1
#endif
#define EN(k) (ONLY < 0 || ONLY == (k))
    if (ph == 0) { if constexpr (EN(100)) phase_prologue(X, lds); return; }
    if (ph == 1) { if constexpr (EN(101)) { phase_norm0(X); convert_range(X, 0, lds, 0, CV0_P1, 0, X.G); } return; }
    const int l = (ph - 2) / 9, sub0 = (ph - 2) % 9, sub = sub0 < 3 ? sub0 : (sub0 == 3 ? 4 : sub0 + 2);
    switch (sub) {
    case 0: if constexpr (EN(0)) {
        if (l == 0) { convert_range(X, 1, lds, 0, CV1_A / 2, 152, 104); __syncthreads(); }
        { SchedA S; S.init(&X, l); EpiStore E; pg8::gemm_phase<EpiStore, SchedA, true, true>(ldsL, 1024, S, E, X.tid); }
        if (l == 0) { unsigned char* lr = lds_raw; asm volatile("" : "+s"(lr)); convert_range(X, 1, (char*)lr, CV1_A / 2, CV1_A, 152, 104); }
#ifdef REP_A_NOEPI
        { __syncthreads(); SchedA S; S.init(&X, l); EpiNone E; pg8::gemm_phase<EpiNone, SchedA, true, true>(ldsL, 1024, S, E, X.tid); }
#endif
    } break;
    case 1: if constexpr (EN(1)) { {
#ifndef REP_ATTN
#define REP_ATTN 1
#endif
#ifndef REP_STATE
#define REP_STATE 1
#endif
        fourier_fold_rows(X, lds); __syncthreads();
        { const int vcu = (X.c & 7) * 32 + (X.c >> 3);
          attn_unit(X, l, lds, false, vcu >> 5, (vcu >> 4) & 1, vcu & 15); }
        if (l == 0) for (int u = X.G - 1 - X.c; u < 32; u += X.G) attn_unit(X, l, lds, true, u >> 2, (u >> 1) & 1, u & 1);
        ret_state_range(X, l, lds, X.c, X.G, 8 * 8 * 18);
        if (l == 0) { __syncthreads(); convert_range(X, 1, lds, CV1_A, CV1_B, 0, 224); }
    } } break;
    case 2: if constexpr (EN(2)) { {
        { SchedF2 S; S.X = &X; EpiStore E; pg8::gemm_phase<EpiStore, SchedF2, false, true>(ldsL, 2048, S, E, X.tid, 2048, 4096); }
        if (l == 0) { SchedF2c S; S.X = &X; EpiStore E; pg8::gemm_phase<EpiStore, SchedF2c, false, true>(ldsL, 512, S, E, X.tid); }
        if (X.c >= 192) { const int u = X.c - 192; ret_scan_unit(X, l, u >> 3, u & 7); ret_scan_publish(X, l, u >> 3, u & 7); }
        { const int nc = (l == 0) ? 18 : 16, c0 = (l == 0) ? 0 : 2, NU = 64 * nc;
          ret_scan_wait_all(X, l);
#ifndef REP_RETOUT
#define REP_RETOUT 1
#endif
          if (X.c >= 128) ret_out_range(X, l, lds, X.c - 128, 128, 6, nc, c0);
          else ret_out_range(X, l, lds, 768 + X.c, 128, (NU - 768 - X.c + 127) / 128, nc, c0); }
    } } break;
    case 4: if constexpr (EN(4)) { { SchedM S; S.init(&X, l); EpiMerge E; pg8::gemm_phase<EpiMerge, SchedM, true, true>(ldsL, 512, S, E, X.tid); }
        merge_publish(X, l);
        { SchedO S; S.init(&X, l); out_wait(X, S); EpiOut E; pg8::gemm_phase<EpiOut, SchedO, true, true>(ldsL, 1024, S, E, X.tid); }
        if (l == 0) convert_range(X, 0, lds, CV0_P1, N_CONV_ITEMS, 96, 160); } break;
    case 6: if constexpr (EN(6)) { phase_route(X, l, lds); } break;
    case 7: if constexpr (EN(7)) { phase_sortcopy(X, l, lds); } break;
    case 8: if constexpr (EN(8)) { { LAS int* tb = (LAS int*)(ldsL + LDS_TBL); build_expert_table(X, l, tb); SchedE S; S.X = &X; S.tb = tb; S.which = 1; S.l = l; EpiGU E;
        const int rem1 = (l == 0) ? (tb[96] * 4) % X.G : 0; constexpr int CVH = (CV1_B + N_CONV_ITEMS) / 2;
        if (rem1 != 0) { convert_range(X, 1, lds, CV1_B, CVH, rem1, X.G - rem1); __syncthreads(); }
        pg8::gemm_phase<EpiGU, SchedE, true, true, true>(ldsL, 1024, S, E, X.tid);
        if (rem1 != 0) { unsigned char* lr = lds_raw; asm volatile("" : "+s"(lr)); __syncthreads(); convert_range(X, 1, (char*)lr, CVH, N_CONV_ITEMS, rem1, X.G - rem1); } } } break;
    case 9: if constexpr (EN(9)) { { LAS int* tb = (LAS int*)(ldsL + LDS_TBL); build_expert_table(X, l, tb); SchedE S; S.X = &X; S.tb = tb; S.which = 2; S.l = l; EpiDown E; pg8::gemm_phase<EpiDown, SchedE, true, true>(ldsL, 512, S, E, X.tid);
        if (l == 0) { const int rem = (tb[96] * 4) % X.G; if (rem != 0) { unsigned char* lr = lds_raw; asm volatile("" : "+s"(lr)); small_weights(X, (char*)lr, 1, rem, X.G - rem); } } } } break;
    case 10: if constexpr (EN(10)) { { phase_combine(X, l); if (l == 0) { LAS int* tb = (LAS int*)(ldsL + LDS_TBL); build_expert_table(X, 0, tb); if ((tb[96] * 4) % X.G == 0) { convert_range(X, 1, lds, CV1_B, N_CONV_ITEMS, 0, X.G); small_weights(X, lds, 1, 0, X.G); } } } } break;
    }
}

__global__ void __launch_bounds__(512, 2) fwd_kernel(Params p) {
    extern __shared__ __attribute__((aligned(16))) unsigned char lds_raw[];
    const int wave_s = __builtin_amdgcn_readfirstlane((int)threadIdx.x >> 6);
    volatile LAS unsigned* bst = (volatile LAS unsigned*)((LAS unsigned char*)lds_raw + LDS_BYTES - 64);
    if (threadIdx.x < 2) bst[threadIdx.x] = 0u;
    __syncthreads();
    if (p.ph_hi < 0) cg::this_grid().sync();
    XcdBarrier xbar; xbar.bar = nullptr; xbar.x = 0; xbar.st = bst;
    if (p.ph_hi - p.ph_lo > 1) xbar = xcd_barrier_post((unsigned*)(p.ws + WS_CTL) + CW_BAR, bst);
#define SEAM(k) do { { unsigned am2_ = ~0u; asm volatile("" : "+s"(am2_)); const int t2_ = wave_s * 64 + (int)__builtin_amdgcn_mbcnt_hi(am2_, __builtin_amdgcn_mbcnt_lo(am2_, 0u)); xcd_barrier(xbar, t2_); } } while (0)
#define MAKE_CTX(X) Ctx X; { unsigned am_ = ~0u; asm volatile("" : "+s"(am_)); int t = wave_s * 64 + (int)__builtin_amdgcn_mbcnt_hi(am_, __builtin_amdgcn_mbcnt_lo(am_, 0u)), c = blockIdx.x; KParams kp = (KParams)__builtin_amdgcn_kernarg_segment_ptr(); asm volatile("" : "+v"(t), "+s"(c), "+s"(kp)); X.tid = t; X.c = c; X.P = kp; } X.out = X.P->out; X.ws = X.P->ws; X.G = gridDim.x;
    if (p.ph_lo <= 0 && 0 < p.ph_hi) { MAKE_CTX(X); run_phase(X, 0, lds_raw); if (1 < p.ph_hi) SEAM(0); }
    if (p.ph_lo <= 1 && 1 < p.ph_hi) { MAKE_CTX(X); run_phase(X, 1, lds_raw); if (2 < p.ph_hi) SEAM(1); }
    for (int ph = p.ph_lo < 2 ? 2 : p.ph_lo; ph < p.ph_hi; ++ph) {
        MAKE_CTX(X);
        run_phase(X, ph, lds_raw);
        if (ph + 1 < p.ph_hi) SEAM(ph);
    }
}

extern "C" void kernel_launch(void* const* d_in, const int* in_sizes, int n_in, void* d_out, int out_size, void* d_ws, size_t ws_size, hipStream_t stream) {
    static int grid = 0;
    if (grid == 0) {
        if (n_in != 24 || out_size != R_LAT * D || ws_size < WS_END) { fprintf(stderr, "kernel_launch: unexpected problem (n_in %d, out %d, ws %zu < %zu)\n", n_in, out_size, ws_size, (size_t)WS_END); grid = -1; return; }
        if (hipFuncSetAttribute((const void*)fwd_kernel, hipFuncAttributeMaxDynamicSharedMemorySize, LDS_BYTES) != hipSuccess) { fprintf(stderr, "kernel_launch: hipFuncSetAttribute failed\n"); grid = -1; return; }
        int dev = 0, cus = 0, per_cu = 0; hipGetDevice(&dev); hipDeviceGetAttribute(&cus, hipDeviceAttributeMultiprocessorCount, dev);
        hipOccupancyMaxActiveBlocksPerMultiprocessor(&per_cu, (const void*)fwd_kernel, 512, LDS_BYTES);
        (void)hipGetLastError();
        if (cus != 256 || per_cu < 1) { fprintf(stderr, "kernel_launch: needs 256 CUs with one resident workgroup each (cus %d, per_cu %d)\n", cus, per_cu); }
        grid = 256;
    }
    if (grid < 0) return;
    hipMemsetAsync((char*)d_ws + WS_CTL, 0, CTL_BYTES, stream);
    Params p{};
    for (int i = 0; i < 24; ++i) p.in[i] = (const float*)d_in[i];
    p.out = (float*)d_out; p.ws = (unsigned char*)d_ws;
#if MK_LAUNCHES == 1
    p.ph_lo = 0; p.ph_hi = N_PHASES;
    void* args[] = {&p};
    hipError_t e = hipLaunchCooperativeKernel((const void*)fwd_kernel, dim3(grid), dim3(512), args, LDS_BYTES, stream);
    if (e != hipSuccess) fprintf(stderr, "cooperative launch failed: %s\n", hipGetErrorString(e));
#else
    for (int ph = 0; ph < N_PHASES; ++ph) { p.ph_lo = ph; p.ph_hi = ph + 1; hipLaunchKernelGGL(fwd_kernel, dim3(grid), dim3(512), LDS_BYTES, stream, p);
#ifdef PROBE_REPEAT
        if (ph == PROBE_REPEAT) for (int rr = 0; rr < PROBE_TIMES; ++rr) hipLaunchKernelGGL(fwd_kernel, dim3(grid), dim3(512), LDS_BYTES, stream, p);
#endif
    }
#endif
}
```

```cpp
#include <hip/hip_runtime.h>
#define MK_LAUNCHES 1
#include <hip/hip_cooperative_groups.h>
#include <cstdio>
#include <cstdint>
namespace cg = cooperative_groups;

#define DI __device__ __forceinline__
#define LAS __attribute__((address_space(3)))
typedef unsigned short bf16_t;
typedef short bf16x8 __attribute__((ext_vector_type(8)));
typedef short s16x4 __attribute__((ext_vector_type(4)));
typedef float f32x2 __attribute__((ext_vector_type(2)));
typedef float f32x4 __attribute__((ext_vector_type(4)));
typedef float f32x16 __attribute__((ext_vector_type(16)));
typedef unsigned u32x2 __attribute__((ext_vector_type(2)));
typedef unsigned u32x4 __attribute__((ext_vector_type(4)));
typedef __bf16 bf16x2_t __attribute__((ext_vector_type(2)));

DI unsigned pk2(float lo, float hi) { f32x2 v = {lo, hi}; bf16x2_t b = __builtin_convertvector(v, bf16x2_t); return __builtin_bit_cast(unsigned, b); }
DI float bflo(unsigned u) { return __uint_as_float(u << 16); }
DI float bfhi(unsigned u) { return __uint_as_float(u & 0xffff0000u); }
DI float bf2f(bf16_t b) { return __uint_as_float((unsigned)b << 16); }
DI bf16_t f2bf(float f) { return (bf16_t)(pk2(f, 0.f) & 0xffffu); }
DI float fast_exp2(float x) { return __builtin_amdgcn_exp2f(x); }
DI float sigmoidf_(float x) { return __builtin_amdgcn_rcpf(1.0f + __expf(-x)); }
DI float siluf_(float x) { return x * __builtin_amdgcn_rcpf(1.0f + __expf(-x)); }
DI const float* opaque_ptr(const float* p) { asm volatile("" : "+s"(p)); return p; }
DI float shx(float v, int m, int lane) { return __int_as_float(__builtin_amdgcn_ds_bpermute((lane ^ m) << 2, __float_as_int(v))); }
DI float wave_sum(float v, int lane) {
#pragma unroll
    for (int o = 1; o < 64; o <<= 1) v += shx(v, o, lane);
    return v;
}
DI void sincos_d(double x, double& s, double& c) {
    const double inv = 0.63661977236758134308;
    const double q = __builtin_rint(x * inv);
    const double p1 = 1.57079632673412561417e+00, p2 = 6.07710050650619224932e-11, p3 = 2.02226624879595063154e-21;
    double r = x - q * p1; r -= q * p2; r -= q * p3;
    const double r2 = r * r;
    double sp = -1.0 / 121645100408832000.0;
    sp = sp * r2 + 1.0 / 355687428096000.0;
    sp = sp * r2 - 1.0 / 1307674368000.0;
    sp = sp * r2 + 1.0 / 6227020800.0;
    sp = sp * r2 - 1.0 / 39916800.0;
    sp = sp * r2 + 1.0 / 362880.0;
    sp = sp * r2 - 1.0 / 5040.0;
    sp = sp * r2 + 1.0 / 120.0;
    sp = sp * r2 - 1.0 / 6.0;
    const double sr = r + r * r2 * sp;
    double cp = 1.0 / 6402373705728000.0;
    cp = cp * r2 - 1.0 / 20922789888000.0;
    cp = cp * r2 + 1.0 / 87178291200.0;
    cp = cp * r2 - 1.0 / 479001600.0;
    cp = cp * r2 + 1.0 / 3628800.0;
    cp = cp * r2 - 1.0 / 40320.0;
    cp = cp * r2 + 1.0 / 720.0;
    cp = cp * r2 - 1.0 / 24.0;
    cp = cp * r2 + 0.5;
    const double cr = 1.0 - r2 * cp;
    const int qi = (int)q & 3;
    s = (qi == 0) ? sr : (qi == 1) ? cr : (qi == 2) ? -sr : -cr;
    c = (qi == 0) ? cr : (qi == 1) ? -sr : (qi == 2) ? -cr : sr;
}

namespace pg8 {
constexpr int BM = 256, BK = 64, HALF = 128, HTB = HALF * BK * 2, STAGE_BYTES = 8 * HTB;
DI int lds_byte(int r, int c) { const int st = (r >> 4) * 2 + (c >> 5), rr = r & 15, cc = c & 31, ob = rr * 64 + cc * 2; return st * 1024 + (ob ^ (((ob >> 9) & 1) << 5)); }
DI void stage_rc(int b, int& R, int& C) { const int st = b / 1024, sb = b % 1024, swz = sb ^ (((sb >> 9) & 1) << 5); R = (st >> 1) * 16 + swz / 64; C = (st & 1) * 32 + (swz % 64) / 2; }
DI int perm32(int rho) { const int n = rho >> 4, i = rho & 15; return 8 * (i >> 2) + 4 * n + (i & 3); }

struct Unit { const char* a; const char* b; void* o0; const void* o1; const void* o2; int ld; int rows; int flag; const int* gidx; };

template <class Epi, class Sched, bool ALIGN_EPI, bool SP2, bool GATHER = false>
DI void gemm_phase(LAS unsigned char* lds, const int K, const Sched& S, const Epi& E, const int tid, const int lda = 0, const int ldb = 0) {
    const int LA = lda ? lda : K, LB = ldb ? ldb : K;
    const int  wid = __builtin_amdgcn_readfirstlane(tid >> 6), lane = tid & 63, wr = wid >> 2, wc = wid & 3, fr = lane & 15, fq = lane >> 4;
    const int nt = K / BK;
    unsigned voffA[2], voffB[2];
#pragma unroll
    for (int i = 0; i < 2; ++i) { int R, C; stage_rc(tid * 16 + i * 8192, R, C); const int Rb = Epi::PERM ? ((R & ~31) + perm32(R & 31)) : R;
        voffA[i] = (unsigned)(R * LA + C) * 2u; voffB[i] = (unsigned)(Rb * LB + C) * 2u; }
    const size_t kstep = (size_t)(BK * 2);
    const size_t hstepA = (size_t)HALF * LA * 2, hstepB = (size_t)HALF * LB * 2;
    const unsigned ldsw = (unsigned)wid * 1024u;
    const int aoff = lds_byte(wr * 64 + fr, fq * 8), boff = lds_byte(wc * 32 + fr, fq * 8);
#define PG8_SA(b, h) (((b) * 2 + (h)) * HTB)
#define PG8_SB(b, h) ((4 + (b) * 2 + (h)) * HTB)
#define PG8_STAGE(bufoff, gbase, voff) do { _Pragma("unroll") for (int _i = 0; _i < 2; ++_i) \
        __builtin_amdgcn_global_load_lds((const unsigned*)((const char*)(gbase) + (voff)[_i]), (LAS unsigned*)(lds + (bufoff) + ldsw + _i * 8192), 16, 0, 0); } while (0)
#define PG8_STAGE_A(bufoff, gbase, half, nextu) do { if constexpr (GATHER) { _Pragma("unroll") for (int _i = 0; _i < 2; ++_i) { const unsigned _o = (nextu) ? gnx[half][_i] : gof[half][_i]; \
        __builtin_amdgcn_global_load_lds((const unsigned*)((const char*)(gbase) + _o), (LAS unsigned*)(lds + (bufoff) + ldsw + _i * 8192), 16, 0, 0); } } \
        else { PG8_STAGE(bufoff, (gbase) + ((half) ? hstepA : 0), voffA); } } while (0)
#define PG8_LDA(dst, b, h) do { _Pragma("unroll") for (int m = 0; m < 4; ++m) _Pragma("unroll") for (int k = 0; k < 2; ++k) dst[m][k] = *(const LAS bf16x8*)(lds + PG8_SA(b, h) + aoff + m * 2048 + k * 1024); } while (0)
#define PG8_LDB(dst, b, h) do { _Pragma("unroll") for (int n = 0; n < 2; ++n) _Pragma("unroll") for (int k = 0; k < 2; ++k) dst[n][k] = *(const LAS bf16x8*)(lds + PG8_SB(b, h) + boff + n * 2048 + k * 1024); } while (0)
#define PG8_MMA(ai, bj, At, Bt) do { __builtin_amdgcn_s_setprio(1); _Pragma("unroll") for (int m = 0; m < 4; ++m) _Pragma("unroll") for (int n = 0; n < 2; ++n) _Pragma("unroll") for (int k = 0; k < 2; ++k) \
        acc[ai][bj][m][n] = __builtin_amdgcn_mfma_f32_16x16x32_bf16(Bt[n][k], At[m][k], acc[ai][bj][m][n], 0, 0, 0); __builtin_amdgcn_s_setprio(0); } while (0)
#define PG8_WAIT_V(n) asm volatile("s_waitcnt vmcnt(" #n ")" ::: "memory")
#define PG8_WAIT_L(n) asm volatile("s_waitcnt lgkmcnt(" #n ")" ::: "memory")
#define PG8_BAR __builtin_amdgcn_s_barrier()
#define PG8_SCHED __builtin_amdgcn_sched_barrier(0)
    Unit cur, nxt; int ui = 0;
    if (!S.next(0, cur)) return;
    unsigned gof[2][2], gnx[2][2];
    if constexpr (GATHER) {
#pragma unroll
        for (int hh = 0; hh < 2; ++hh)
#pragma unroll
            for (int i = 0; i < 2; ++i) { int gR, gC; stage_rc(tid * 16 + i * 8192, gR, gC); const int r = hh * HALF + gR; const int row = (r < cur.rows) ? (cur.gidx[r] >> 1) : 0; gof[hh][i] = (unsigned)(row * LA + gC) * 2u; gnx[hh][i] = gof[hh][i]; }
    }
    f32x4 acc[2][2][4][2];
#pragma unroll
    for (int a = 0; a < 2; ++a)
#pragma unroll
        for (int b = 0; b < 2; ++b)
#pragma unroll
            for (int m = 0; m < 4; ++m)
#pragma unroll
                for (int n = 0; n < 2; ++n) acc[a][b][m][n] = (f32x4){0.f, 0.f, 0.f, 0.f};
    bf16x8 At[4][2], B0[2][2], B1[2][2];
    const char* cA = cur.a; const char* cB = cur.b;
    if constexpr (SP2) {
        PG8_STAGE(PG8_SB(0, 0), cB, voffB); PG8_STAGE(PG8_SB(0, 1), cB + hstepB, voffB); PG8_STAGE_A(PG8_SA(0, 0), cA, 0, false); PG8_STAGE_A(PG8_SA(0, 1), cA, 1, false);
        if (wr == 1) PG8_BAR;
        PG8_WAIT_V(2); PG8_BAR;
        PG8_STAGE(PG8_SB(1, 0), cB + kstep, voffB); PG8_STAGE_A(PG8_SA(1, 0), cA + kstep, 0, false); PG8_STAGE(PG8_SB(1, 1), cB + hstepB + kstep, voffB);
        PG8_WAIT_V(6); PG8_BAR;
    } else {
        PG8_STAGE(PG8_SB(0, 0), cB, voffB); PG8_STAGE_A(PG8_SA(0, 0), cA, 0, false); PG8_STAGE(PG8_SB(0, 1), cB + hstepB, voffB); PG8_STAGE_A(PG8_SA(0, 1), cA, 1, false);
        if (wr == 1) PG8_BAR;
        PG8_WAIT_V(4); PG8_BAR;
        PG8_STAGE(PG8_SB(1, 0), cB + kstep, voffB); PG8_STAGE_A(PG8_SA(1, 0), cA + kstep, 0, false); PG8_STAGE(PG8_SB(1, 1), cB + hstepB + kstep, voffB);
        PG8_WAIT_V(6); PG8_BAR;
    }
    for (;;) {
        const bool has_next = S.next(ui + 1, nxt);
        if constexpr (GATHER) { if (has_next) {
#pragma unroll
            for (int hh = 0; hh < 2; ++hh)
#pragma unroll
                for (int i = 0; i < 2; ++i) { int t2 = tid; asm volatile("" : "+v"(t2)); int gR, gC; stage_rc(t2 * 16 + i * 8192, gR, gC); const int r = hh * HALF + gR; const int row = (r < nxt.rows) ? (nxt.gidx[r] >> 1) : 0; gnx[hh][i] = (unsigned)(row * LA + gC) * 2u; } } }
        const char* nA = has_next ? nxt.a : cA; const char* nB = has_next ? nxt.b : cB;
        for (int t = 0; t < nt; t += 2) {
            const bool last = (t == nt - 2);
            const char* a1 = cA + (size_t)(t + 1) * kstep;
            const char* a2 = last ? nA : cA + (size_t)(t + 2) * kstep; const char* b2 = last ? nB : cB + (size_t)(t + 2) * kstep;
            const char* a3 = a2 + kstep; const char* b3 = b2 + kstep;
            if constexpr (SP2) {
            PG8_LDB(B0, 0, 0); PG8_LDB(B1, 0, 1); PG8_SCHED; PG8_LDA(At, 0, 0); PG8_STAGE_A(PG8_SA(1, 1), a1, 1, false);
            PG8_WAIT_V(8); PG8_WAIT_L(0); PG8_BAR; PG8_MMA(0, 0, At, B0); PG8_MMA(0, 1, At, B1); PG8_BAR; PG8_SCHED;
            PG8_LDA(At, 0, 1); PG8_STAGE(PG8_SB(0, 0), b2, voffB); PG8_STAGE(PG8_SB(0, 1), b2 + hstepB, voffB); PG8_STAGE_A(PG8_SA(0, 0), a2, 0, last);
            PG8_WAIT_V(8); PG8_WAIT_L(0); PG8_BAR; PG8_MMA(1, 0, At, B0); PG8_MMA(1, 1, At, B1); PG8_BAR; PG8_SCHED;
            PG8_LDB(B0, 1, 0); PG8_LDB(B1, 1, 1); PG8_SCHED; PG8_LDA(At, 1, 0); PG8_STAGE_A(PG8_SA(0, 1), a2, 1, last);
            PG8_WAIT_V(8); PG8_WAIT_L(0); PG8_BAR; PG8_MMA(0, 0, At, B0); PG8_MMA(0, 1, At, B1); PG8_BAR; PG8_SCHED;
            PG8_LDA(At, 1, 1); PG8_STAGE(PG8_SB(1, 0), b3, voffB); PG8_STAGE(PG8_SB(1, 1), b3 + hstepB, voffB); PG8_STAGE_A(PG8_SA(1, 0), a3, 0, last);
            PG8_WAIT_V(8); PG8_WAIT_L(0); PG8_BAR; PG8_MMA(1, 0, At, B0); PG8_MMA(1, 1, At, B1); PG8_BAR; PG8_SCHED;
            } else {
            PG8_LDB(B0, 0, 0); PG8_SCHED; PG8_LDA(At, 0, 0); PG8_STAGE_A(PG8_SA(1, 1), a1, 1, false);
            PG8_WAIT_L(8); PG8_BAR; PG8_WAIT_L(0); PG8_MMA(0, 0, At, B0); PG8_BAR; PG8_SCHED;
            PG8_LDB(B1, 0, 1); PG8_STAGE(PG8_SB(0, 0), b2, voffB);
            PG8_BAR; PG8_WAIT_L(0); PG8_MMA(0, 1, At, B1); PG8_BAR;
            PG8_LDA(At, 0, 1); PG8_STAGE_A(PG8_SA(0, 0), a2, 0, last);
            PG8_BAR; PG8_WAIT_L(0); PG8_MMA(1, 0, At, B0); PG8_BAR; PG8_SCHED;
            PG8_STAGE(PG8_SB(0, 1), b2 + hstepB, voffB);
            PG8_WAIT_V(6); PG8_BAR; PG8_MMA(1, 1, At, B1); PG8_BAR;
            PG8_LDB(B0, 1, 0); PG8_SCHED; PG8_LDA(At, 1, 0); PG8_STAGE_A(PG8_SA(0, 1), a2, 1, last);
            PG8_WAIT_L(8); PG8_BAR; PG8_WAIT_L(0); PG8_MMA(0, 0, At, B0); PG8_BAR; PG8_SCHED;
            PG8_LDB(B1, 1, 1); PG8_STAGE(PG8_SB(1, 0), b3, voffB);
            PG8_BAR; PG8_WAIT_L(0); PG8_MMA(0, 1, At, B1); PG8_BAR;
            PG8_LDA(At, 1, 1); PG8_STAGE_A(PG8_SA(1, 0), a3, 0, last);
            PG8_BAR; PG8_WAIT_L(0); PG8_MMA(1, 0, At, B0); PG8_BAR; PG8_SCHED;
            PG8_STAGE(PG8_SB(1, 1), b3 + hstepB, voffB);
            PG8_WAIT_V(6); PG8_BAR; PG8_MMA(1, 1, At, B1); PG8_BAR;
            }
        }
        if constexpr (ALIGN_EPI) { if (wr == 0) PG8_BAR; }
        const bool keep = E(acc, cur, wr, wc, fr, fq);
        if (!has_next) break;
        if (!keep) {
#pragma unroll
        for (int a = 0; a < 2; ++a)
#pragma unroll
            for (int b = 0; b < 2; ++b)
#pragma unroll
                for (int m = 0; m < 4; ++m)
#pragma unroll
                    for (int n = 0; n < 2; ++n) acc[a][b][m][n] = (f32x4){0.f, 0.f, 0.f, 0.f};
        }
        if constexpr (GATHER) {
#pragma unroll
            for (int hh = 0; hh < 2; ++hh)
#pragma unroll
                for (int i = 0; i < 2; ++i) gof[hh][i] = gnx[hh][i]; }
        cur = nxt; cA = nA; cB = nB; ++ui;
        if constexpr (ALIGN_EPI) { if (wr == 1) PG8_BAR; }
    }
    PG8_WAIT_V(0);
    if constexpr (!ALIGN_EPI) { if (wr == 0) PG8_BAR; }
    PG8_BAR;
#undef PG8_SA
#undef PG8_SB
#undef PG8_STAGE
#undef PG8_STAGE_A
#undef PG8_LDA
#undef PG8_LDB
#undef PG8_MMA
#undef PG8_WAIT_V
#undef PG8_WAIT_L
#undef PG8_BAR
#undef PG8_SCHED
}
}
constexpr int D = 1024, NB = 8, NSEQ = 2048, LCTX = 256, DEPTH = 2;
constexpr int R_CTX = NB * LCTX, R_LAT = NB * NSEQ, R_ALL = R_CTX + R_LAT;
constexpr int IN_COLS = 6400, PCOLS = 5888;
constexpr int HM_COLS = 2816, GATE_LD = 3072;
constexpr int PC_QA = 0, PC_KA = 512, PC_VA = 640, PC_QR = 768, PC_KR = 1280, PC_VR = 1792, PC_GR = 2304, PC_GATE = 2816;
constexpr int OC_FU = 2816, OC_GATE = 3328;
constexpr int NEXP = 32, EH = 512;
constexpr int P_ROWS = 2 * R_ALL + 256;
constexpr size_t MiB = 1u << 20, KiB = 1u << 10;
constexpr size_t WS_CTL = 0, CTL_BYTES = 256 * KiB;
constexpr size_t WS_TAB = 256 * KiB, WS_MODS = 832 * KiB, WS_ROUTE = 1264 * KiB, WS_FL = 1904 * KiB, WS_UTC = 2304 * KiB, WS_FN = WS_UTC + 4 * MiB;
constexpr size_t WS_WSMALL = WS_FN + 16 * MiB, WSMALL_LAYER = (size_t)(18.5 * MiB);
constexpr size_t WO_WIN = 0, WO_WF = (size_t)(11.5 * MiB), WO_WBA = (size_t)(13.5 * MiB), WO_WBF = (size_t)(14.5 * MiB), WO_WBR = (size_t)(15.5 * MiB), WO_WOUT = (size_t)(16.5 * MiB);
constexpr size_t WS_WGU = WS_WSMALL + 37 * MiB, WS_WD = WS_WGU + 64 * MiB;
constexpr size_t WS_H = WS_WD + 32 * MiB;
constexpr size_t WS_SST = WS_H + 36 * MiB;
constexpr size_t WS_OA = WS_SST + 18 * MiB, WS_OF = WS_OA + 18 * MiB, WS_UT = WS_OF + 18 * MiB, WS_RET = WS_UT + 32 * MiB;
constexpr size_t WS_XL = WS_RET + 18 * MiB;
constexpr size_t WS_W0GU = WS_XL + 36 * MiB, WS_W0D = WS_W0GU + 64 * MiB;
constexpr size_t WS_PROJ = WS_W0GU + 24 * MiB;
constexpr size_t WS_XG = WS_PROJ, WS_ACT = WS_XG + (size_t)P_ROWS * 1024 * 2, WS_YS = WS_ACT + (size_t)P_ROWS * 512 * 2;
constexpr size_t WS_END = WS_PROJ + (size_t)R_ALL * PCOLS * 2;
static_assert(WS_W0D + 32 * MiB <= WS_XG + (size_t)P_ROWS * 1024 * 2 && WS_W0D + 32 * MiB <= WS_PROJ + (size_t)HM_COLS * R_ALL * 2, "layer-0 expert weights end inside the dead head-major part of proj, below the act buffer");
static_assert(WS_YS + (size_t)P_ROWS * 1024 * 2 <= WS_END, "MoE buffers fit in the proj region");
constexpr size_t WS_WRT = WS_END, WS_END2 = WS_WRT + (size_t)2 * 2 * 64 * 1024 * 2;
static_assert(WS_END2 <= 602284512ull, "workspace map must fit sum(inputs) bytes");
static_assert(WS_TAB + (16384 + 2 * 65536) * 4 <= WS_MODS && WS_MODS + 2 * 9 * 6144 * 4 <= WS_ROUTE && WS_ROUTE + 640 * KiB <= WS_FL && WS_FL + 256 * KiB <= WS_UTC, "small regions");
constexpr int CW_BLK = 16384;
constexpr int CW_BAR = 4096;
constexpr int CW_PANEL = 49152;
constexpr int CW_FLAG = 32768;
constexpr int TB_ROWC = 0, TB_ROWS = 512, TB_COLC = 1024, TB_COLS = 2048, TB_LG = 3072  , TB_RETC = 16384, TB_RETS = 16384 + 65536;
constexpr size_t RT_TOKE = 0, RT_TOKW = 160 * 1024, RT_SDST = 320 * 1024, RT_SW = 480 * 1024;
constexpr int LDS_BYTES = 155648;
constexpr int LDS_TBL = 131072;

struct EpiStore {
    static constexpr bool PERM = true;
    DI bool operator()(f32x4 (&acc)[2][2][4][2], const pg8::Unit& u, int wr, int wc, int fr_, int fq_) const {
        int fr = fr_, fq = fq_; asm volatile("" : "+v"(fr), "+v"(fq));
        bf16_t* O = (bf16_t*)u.o0; const int ld = u.ld; const bool hm = u.flag == 2;
#pragma unroll
        for (int ai = 0; ai < 2; ++ai)
#pragma unroll
            for (int m = 0; m < 4; ++m) { const int r = ai * 128 + wr * 64 + m * 16 + fr;
                if (hm) {
#pragma unroll
                    for (int bj = 0; bj < 2; ++bj) { const int cc = bj * 128 + wc * 32 + 8 * fq; const f32x4 v0 = acc[ai][bj][m][0], v1 = acc[ai][bj][m][1];
                        u32x4 w; w.x = pk2(v0[0], v0[1]); w.y = pk2(v0[2], v0[3]); w.z = pk2(v1[0], v1[1]); w.w = pk2(v1[2], v1[3]);
                        *(u32x4*)(O + ((size_t)(cc >> 6) * R_ALL + r) * 64 + (cc & 63)) = w; }
                } else
                if (r < u.rows) { bf16_t* rowp = O + (size_t)r * ld + wc * 32 + 8 * fq;
#pragma unroll
                    for (int bj = 0; bj < 2; ++bj) { const f32x4 v0 = acc[ai][bj][m][0], v1 = acc[ai][bj][m][1];
                        u32x4 w; w.x = pk2(v0[0], v0[1]); w.y = pk2(v0[2], v0[3]); w.z = pk2(v1[0], v1[1]); w.w = pk2(v1[2], v1[3]);
                        *(u32x4*)(rowp + bj * 128) = w; } } }
        return false;
    }
};
struct EpiNone { static constexpr bool PERM = true; DI bool operator()(f32x4 (&acc)[2][2][4][2], const pg8::Unit& u, int wr, int wc, int fr, int fq) const {
#pragma unroll
    for (int a = 0; a < 2; ++a)
#pragma unroll
        for (int b = 0; b < 2; ++b)
#pragma unroll
            for (int m = 0; m < 4; ++m)
#pragma unroll
                for (int n = 0; n < 2; ++n) asm volatile("" :: "v"(acc[a][b][m][n])); return false; } };
struct EpiMerge {
    static constexpr bool PERM = true;
    DI bool operator()(f32x4 (&acc)[2][2][4][2], const pg8::Unit& u, int wr, int wc, int fr_, int fq_) const {
        int fr = fr_, fq = fq_; asm volatile("" : "+v"(fr), "+v"(fq));
        bf16_t* M = (bf16_t*)u.o0; const bf16_t* G = (const bf16_t*)u.o1; const int br = u.flag;
        if (br < 2) {
#pragma unroll
            for (int ai = 0; ai < 2; ++ai) {
                u32x4 gc[4][2], gn[4][2];
#pragma unroll
                for (int m = 0; m < 4; ++m) { const int r = ai * 128 + wr * 64 + m * 16 + fr;
#pragma unroll
                    for (int bj = 0; bj < 2; ++bj) { const bf16_t* gp = G + (size_t)r * GATE_LD + wc * 32 + 8 * fq + bj * 128; gc[m][bj] = *(const u32x4*)gp; gn[m][bj] = *(const u32x4*)(gp + 1024); } }
#pragma unroll
                for (int m = 0; m < 4; ++m)
#pragma unroll
                    for (int bj = 0; bj < 2; ++bj) { const u32x4 c = gc[m][bj], n = gn[m][bj];
#define RATIO(xc, xn) ((1.0f + __expf(-fminf(fmaxf((xn), -30.f), 30.f))) * __builtin_amdgcn_rcpf(1.0f + __expf(-fminf(fmaxf((xc), -30.f), 30.f))))
                        f32x4& v0 = acc[ai][bj][m][0]; f32x4& v1 = acc[ai][bj][m][1];
                        v0[0] *= RATIO(bflo(c.x), bflo(n.x)); v0[1] *= RATIO(bfhi(c.x), bfhi(n.x)); v0[2] *= RATIO(bflo(c.y), bflo(n.y)); v0[3] *= RATIO(bfhi(c.y), bfhi(n.y));
                        v1[0] *= RATIO(bflo(c.z), bflo(n.z)); v1[1] *= RATIO(bfhi(c.z), bfhi(n.z)); v1[2] *= RATIO(bflo(c.w), bflo(n.w)); v1[3] *= RATIO(bfhi(c.w), bfhi(n.w));
#undef RATIO
                    }
            }
            return true;
        }
#pragma unroll
        for (int ai = 0; ai < 2; ++ai) {
            u32x4 gq[4][2];
#pragma unroll
            for (int m = 0; m < 4; ++m) { const int r = ai * 128 + wr * 64 + m * 16 + fr;
#pragma unroll
                for (int bj = 0; bj < 2; ++bj) gq[m][bj] = *(const u32x4*)(G + (size_t)r * GATE_LD + wc * 32 + 8 * fq + bj * 128); }
#pragma unroll
            for (int m = 0; m < 4; ++m) { const int r = ai * 128 + wr * 64 + m * 16 + fr; bf16_t* mp = M + (size_t)r * 1024 + wc * 32 + 8 * fq;
#pragma unroll
                for (int bj = 0; bj < 2; ++bj) { const f32x4 v0 = acc[ai][bj][m][0], v1 = acc[ai][bj][m][1]; const u32x4 g = gq[m][bj];
#define SG(x) sigmoidf_(fminf(fmaxf((x), -30.f), 30.f))
                    u32x4 w; w.x = pk2(SG(bflo(g.x)) * v0[0], SG(bfhi(g.x)) * v0[1]); w.y = pk2(SG(bflo(g.y)) * v0[2], SG(bfhi(g.y)) * v0[3]);
                    w.z = pk2(SG(bflo(g.z)) * v1[0], SG(bfhi(g.z)) * v1[1]); w.w = pk2(SG(bflo(g.w)) * v1[2], SG(bfhi(g.w)) * v1[3]);
#undef SG
                    *(u32x4*)(mp + bj * 128) = w; } }
        }
        return false;
    }
};
struct EpiOut {
    static constexpr bool PERM = true;
    DI bool operator()(f32x4 (&acc)[2][2][4][2], const pg8::Unit& u, int wr, int wc, int fr_, int fq_) const {
        int fr = fr_, fq = fq_; asm volatile("" : "+v"(fr), "+v"(fq));
        bf16_t* Dst = (bf16_t*)u.o0; const float* gvec = (const float*)u.o2; const bool f32src = u.flag != 0;
        f32x4 gv[2][2];
#pragma unroll
        for (int bj = 0; bj < 2; ++bj)
#pragma unroll
            for (int n = 0; n < 2; ++n) gv[bj][n] = *(const f32x4*)(gvec + bj * 128 + wc * 32 + 8 * fq + 4 * n);
#pragma unroll
        for (int ai = 0; ai < 2; ++ai) {
            f32x4 sv[4][2][2];
#pragma unroll
            for (int m = 0; m < 4; ++m) { const int r = ai * 128 + wr * 64 + m * 16 + fr;
#pragma unroll
                for (int bj = 0; bj < 2; ++bj) { const size_t off = (size_t)r * 1024 + bj * 128 + wc * 32 + 8 * fq;
                    if (f32src) { const float* sp = (const float*)u.o1 + off; sv[m][bj][0] = *(const f32x4*)sp; sv[m][bj][1] = *(const f32x4*)(sp + 4); }
                    else { const u32x4 q = *(const u32x4*)((const bf16_t*)u.o1 + off); sv[m][bj][0] = (f32x4){bflo(q.x), bfhi(q.x), bflo(q.y), bfhi(q.y)}; sv[m][bj][1] = (f32x4){bflo(q.z), bfhi(q.z), bflo(q.w), bfhi(q.w)}; } } }
#pragma unroll
            for (int m = 0; m < 4; ++m) { const int r = ai * 128 + wr * 64 + m * 16 + fr;
#pragma unroll
                for (int bj = 0; bj < 2; ++bj) { const f32x4 v0 = sv[m][bj][0] + gv[bj][0] * acc[ai][bj][m][0], v1 = sv[m][bj][1] + gv[bj][1] * acc[ai][bj][m][1];
                    u32x4 w; w.x = pk2(v0[0], v0[1]); w.y = pk2(v0[2], v0[3]); w.z = pk2(v1[0], v1[1]); w.w = pk2(v1[2], v1[3]);
                    *(u32x4*)(Dst + (size_t)r * 1024 + bj * 128 + wc * 32 + 8 * fq) = w; } }
        }
        return false;
    }
};
struct EpiGU {
    static constexpr bool PERM = true;
    DI bool operator()(f32x4 (&acc)[2][2][4][2], const pg8::Unit& u, int wr, int wc, int fr_, int fq_) const {
        int fr = fr_, fq = fq_; asm volatile("" : "+v"(fr), "+v"(fq));
        bf16_t* O = (bf16_t*)u.o0;
#pragma unroll
        for (int ai = 0; ai < 2; ++ai)
#pragma unroll
            for (int m = 0; m < 4; ++m) { const int r = ai * 128 + wr * 64 + m * 16 + fr;
                if (r < u.rows) { bf16_t* rowp = O + (size_t)r * 512 + wc * 16 + 4 * fq;
#pragma unroll
                    for (int bj = 0; bj < 2; ++bj) { const f32x4 g = acc[ai][bj][m][0], v = acc[ai][bj][m][1];
                        u32x2 w; w.x = pk2(siluf_(g[0]) * v[0], siluf_(g[1]) * v[1]); w.y = pk2(siluf_(g[2]) * v[2], siluf_(g[3]) * v[3]);
                        *(u32x2*)(rowp + bj * 64) = w; } } }
        return false;
    }
};
struct EpiDown {
    static constexpr bool PERM = true;
    DI bool operator()(f32x4 (&acc)[2][2][4][2], const pg8::Unit& u, int wr, int wc, int fr_, int fq_) const {
        int fr = fr_, fq = fq_; asm volatile("" : "+v"(fr), "+v"(fq));
        bf16_t* Y = (bf16_t*)u.o0; const float* sw = (const float*)u.o2;
        float ww[2][4];
#pragma unroll
        for (int ai = 0; ai < 2; ++ai)
#pragma unroll
            for (int m = 0; m < 4; ++m) { const int r = ai * 128 + wr * 64 + m * 16 + fr; ww[ai][m] = (r < u.rows) ? sw[r] : 0.f; }
#pragma unroll
        for (int ai = 0; ai < 2; ++ai)
#pragma unroll
            for (int m = 0; m < 4; ++m) { const int r = ai * 128 + wr * 64 + m * 16 + fr;
                if (r < u.rows) { const float wt = ww[ai][m]; bf16_t* rowp = Y + (size_t)r * 1024 + wc * 32 + 8 * fq;
#pragma unroll
                    for (int bj = 0; bj < 2; ++bj) { const f32x4 v0 = acc[ai][bj][m][0] * wt, v1 = acc[ai][bj][m][1] * wt;
                        u32x4 w; w.x = pk2(v0[0], v0[1]); w.y = pk2(v0[2], v0[3]); w.z = pk2(v1[0], v1[1]); w.w = pk2(v1[2], v1[3]);
                        *(u32x4*)(rowp + bj * 128) = w; } } }
        return false;
    }
};

DI void tile_of(int L, int nM, int nN, int& pm, int& pn) {
    const int nwg = nM * nN;
    int wgid = L; { const int q = nwg / 8, r = nwg % 8, xcd = wgid % 8, off = wgid / 8; wgid = (xcd < r ? xcd * (q + 1) : r * (q + 1) + (xcd - r) * q) + off; }
    const int nig = 4 * nN, gid = wgid / nig, fm = gid * 4, gsz = (nM - fm) < 4 ? (nM - fm) : 4;
    pm = fm + ((wgid % nig) % gsz); pn = (wgid % nig) / gsz;
}
DI int xcd_remap(int L, int nwg) { const int q = nwg / 8, r = nwg % 8, xcd = L % 8, off = L / 8; return (xcd < r ? xcd * (q + 1) : r * (q + 1) + (xcd - r) * q) + off; }
struct Params { const float* in[24]; float* out; unsigned char* ws; int ph_lo, ph_hi; };
typedef __attribute__((address_space(4))) const Params* KParams;
struct Ctx {
    KParams P; float* out; unsigned char* ws;
    DI const float* in(int i) const { return P->in[i]; }
    int G, c, tid;
};
DI const bf16_t* PJ(const bf16_t* proj, int row, int col) { return proj + ((size_t)(col >> 6) * R_ALL + row) * 64 + (col & 63); }
DI bf16_t* wsmall(const Ctx& X, int l, size_t off) { return (bf16_t*)(X.ws + WS_WSMALL + (size_t)l * WSMALL_LAYER + off); }

struct SchedA {
    const Ctx* X; int l; int n_main, n_ctx, n_f, ftok0, nftok;
    DI void init(const Ctx* X_, int l_) { X = X_; l = l_;
        if (l == 0) { n_main = 72 * 23; n_ctx = 0; ftok0 = 0; nftok = 72; } else { n_main = 64 * 23; n_ctx = 8 * 5; ftok0 = 8; nftok = 64; }
        n_f = 4 * nftok; }
    DI bool next(int i, pg8::Unit& u) const {
        int L = i * X->G + X->c;
        const bf16_t* h = (const bf16_t*)(X->ws + WS_H); bf16_t* proj = (bf16_t*)(X->ws + WS_PROJ);
        u.rows = 256; u.flag = 0; u.o1 = nullptr; u.o2 = nullptr; u.gidx = nullptr;
        if (L < n_main) { int pm, pn; tile_of(L, l == 0 ? 72 : 64, 23, pm, pn); if (l != 0) pm += 8;
            u.a = (const char*)(h + (size_t)pm * 256 * 1024); u.b = (const char*)(wsmall(*X, l, WO_WIN) + (size_t)pn * 256 * 1024);
            if (pn < 11) { u.o0 = proj + ((size_t)(pn * 4) * R_ALL + pm * 256) * 64; u.ld = 64; u.flag = 2; } else { u.o0 = proj + (size_t)HM_COLS * R_ALL + (size_t)pm * 256 * GATE_LD + (pn - 11) * 256; u.ld = GATE_LD; }
            return true; }
        L -= n_main;
        if (L < n_ctx) { const int pm = L / 5, j = L % 5, pn = (j == 0) ? 2 : 4 + j;
            u.a = (const char*)(h + (size_t)pm * 256 * 1024); u.b = (const char*)(wsmall(*X, l, WO_WIN) + (size_t)pn * 256 * 1024);
            u.o0 = proj + ((size_t)(pn * 4) * R_ALL + pm * 256) * 64; u.ld = 64; u.flag = 2; return true; }
        L -= n_ctx;
        if (L < n_f) { const int w = xcd_remap(L, n_f); const int tt = ftok0 + w / 4, pm = w % 4, cs = pm >> 1, colbase = (pm & 1) * 256;
            u.a = (const char*)(wsmall(*X, l, WO_WF) + (size_t)pm * 256 * 1024); u.b = (const char*)(h + (size_t)tt * 256 * 1024);
            if (tt < 8) { u.o0 = (bf16_t*)(X->ws + WS_UTC) + ((size_t)(tt * 512 + colbase)) * 512 + cs * 256; u.ld = 512; }
            else { const int tl = tt - 8, bb = tl >> 3, n0 = (tl & 7) * 256; u.o0 = (bf16_t*)(X->ws + WS_UT) + ((size_t)(bb * 512 + colbase)) * 4096 + cs * 2048 + n0; u.ld = 4096; }
            return true; }
        return false;
    }
};
struct SchedF2 {
    const Ctx* X;
    DI bool next(int i, pg8::Unit& u) const {
        if (i != 0 || X->c >= 128) return false;
        const int L = X->c, b = L >> 4, pm = (L >> 1) & 7, pn = L & 1;
        u.a = (const char*)((const bf16_t*)(X->ws + WS_FN) + (size_t)pm * 256 * 2048); u.b = (const char*)((const bf16_t*)(X->ws + WS_UT) + ((size_t)(b * 512 + pn * 256)) * 4096);
        u.o0 = (bf16_t*)(X->ws + WS_OF) + ((size_t)(R_CTX + b * 2048 + pm * 256)) * 512 + pn * 256; u.ld = 512; u.rows = 256; u.flag = 0; u.o1 = nullptr; u.o2 = nullptr; u.gidx = nullptr; return true;
    }
};
struct SchedF2c {
    const Ctx* X;
    DI bool next(int i, pg8::Unit& u) const {
        if (i != 0 || X->c < 128 || X->c >= 144) return false;
        const int L = X->c - 128, b = L >> 1, pn = L & 1;
        u.a = (const char*)(X->ws + WS_FL); u.b = (const char*)((const bf16_t*)(X->ws + WS_UTC) + ((size_t)(b * 512 + pn * 256)) * 512);
        u.o0 = (bf16_t*)(X->ws + WS_OF) + ((size_t)(b * 256)) * 512 + pn * 256; u.ld = 512; u.rows = 256; u.flag = 0; u.o1 = nullptr; u.o2 = nullptr; u.gidx = nullptr; return true;
    }
};
DI bool merge_tile(int l, int G, int c, int j, int& pm, int& pn) {
    if (l != 0) { if (j != 0 || c >= 256) return false; tile_of(c, 64, 4, pm, pn); pm += 8; return true; }
    if (c >= 32) { if (j != 0 || c - 32 >= 224) return false; tile_of(c - 32, 56, 4, pm, pn); return true; }
    if (j > 1) return false; const int t2 = c * 2 + j; pm = 56 + (t2 >> 2); pn = t2 & 3; return true;
}
struct SchedM {
    const Ctx* X; int l;
    DI void init(const Ctx* X_, int l_) { X = X_; l = l_; }
    DI bool next(int i, pg8::Unit& u) const {
        const int br = i % 3; int pm, pn; if (!merge_tile(l, X->G, X->c, i / 3, pm, pn)) return false;
        const size_t src = (br == 0) ? WS_OA : (br == 1) ? WS_OF : WS_RET; const size_t wo = (br == 0) ? WO_WBA : (br == 1) ? WO_WBF : WO_WBR;
        u.a = (const char*)((const bf16_t*)(X->ws + src) + (size_t)pm * 256 * 512); u.b = (const char*)(wsmall(*X, l, wo) + (size_t)pn * 256 * 512);
        u.o0 = (bf16_t*)(X->ws + WS_H) + (size_t)pm * 256 * 1024 + pn * 256;
        u.o1 = (const bf16_t*)(X->ws + WS_PROJ) + (size_t)HM_COLS * R_ALL + (size_t)pm * 256 * GATE_LD + br * 1024 + pn * 256; u.o2 = nullptr; u.ld = 1024; u.rows = 256; u.flag = br; u.gidx = nullptr; return true;
    }
};
struct SchedO {
    const Ctx* X; int l;
    DI void init(const Ctx* X_, int l_) { X = X_; l = l_; }
    DI bool unit_tile(int i, int& pm, int& pn) const {
        if (l != 0) { if (i != 0) return false; tile_of(X->c, 64, 4, pm, pn); pm += 8; return true; }
        const int idx = X->c - 32; if (idx < 0) return false;
        if (i == 0) { tile_of(idx, 56, 4, pm, pn); return true; }
        if (i == 1 && idx < 64) { pm = 56 + (idx >> 2); pn = idx & 3; return true; }
        return false; }
    DI int panel_of(int i) const { int pm, pn; return unit_tile(i, pm, pn) ? pm : -1; }
    DI bool next(int i, pg8::Unit& u) const {
        int pm, pn; if (!unit_tile(i, pm, pn)) return false;
        u.a = (const char*)((const bf16_t*)(X->ws + WS_H) + (size_t)pm * 256 * 1024); u.b = (const char*)(wsmall(*X, l, WO_WOUT) + (size_t)pn * 256 * 1024);
        bf16_t* xl = (bf16_t*)(X->ws + WS_XL) + (size_t)pm * 256 * 1024 + pn * 256;
        const void* src = (l != 0) ? (const void*)xl : (const void*)(pm < 8 ? X->in(2) + (size_t)pm * 256 * 1024 + pn * 256 : X->in(0) + (size_t)(pm - 8) * 256 * 1024 + pn * 256);
        const int bidx = pm < 8 ? 8 : (pm - 8) >> 3;
        u.o0 = xl; u.o1 = src; u.o2 = (const float*)(X->ws + WS_MODS) + ((size_t)(l * 9 + bidx) * 6 + 2) * 1024 + pn * 256; u.ld = 1024; u.rows = 256; u.flag = (l == 0); u.gidx = nullptr; return true;
    }
};
DI unsigned* panel_cnt(const Ctx& X, int l, int pm) { return (unsigned*)(X.ws + WS_CTL) + CW_PANEL + (l * 72 + pm) * 64; }
DI void merge_publish(const Ctx& X, int l) {
    asm volatile("s_waitcnt vmcnt(0)" ::: "memory");
    __syncthreads();
    if (X.tid == 0) { __builtin_amdgcn_fence(__ATOMIC_RELEASE, "agent"); asm volatile("s_waitcnt vmcnt(0)" ::: "memory");
        for (int j = 0; j < 2; ++j) { int pm, pn; if (!merge_tile(l, X.G, X.c, j, pm, pn)) break; __hip_atomic_fetch_add(panel_cnt(X, l, pm), 1u, __ATOMIC_RELAXED, __HIP_MEMORY_SCOPE_AGENT); } }
}
DI void out_wait(const Ctx& X, const SchedO& S) {
    if (X.tid == 0) {
        for (int i = 0; i < 2; ++i) { const int pm = S.panel_of(i); if (pm < 0) break; unsigned* f = panel_cnt(X, S.l, pm); unsigned sp = 0;
            while (__hip_atomic_load(f, __ATOMIC_RELAXED, __HIP_MEMORY_SCOPE_AGENT) < 4u) { __builtin_amdgcn_s_sleep(2); if (++sp > (1u << 22)) break; } }
        __builtin_amdgcn_fence(__ATOMIC_ACQUIRE, "agent"); asm volatile("s_waitcnt vmcnt(0)" ::: "memory"); }
    __syncthreads();
}
struct SchedE {
    const Ctx* X; const LAS int* tb; int which, l;
    DI bool next(int i, pg8::Unit& u) const {
        const int ntile = tb[96], nwg = ntile * 4; const int L = i * X->G + X->c; if (L >= nwg) return false;
        const int w = xcd_remap(L, nwg), T = w >> 2, pn = w & 3;
        int e = 0;
#pragma unroll 1
        for (int k = 1; k < 32; ++k) if (tb[64 + k] <= T) e = k;
        const int j = T - tb[64 + e], row0 = tb[e] + 256 * j; int rows = tb[32 + e] - 256 * j; rows = rows > 256 ? 256 : rows;
        u.rows = rows; u.flag = 0; u.gidx = (const int*)(X->ws + WS_ROUTE + RT_SDST) + row0;
        if (which == 1) { u.a = (const char*)(X->ws + WS_H); u.b = (const char*)((const bf16_t*)(X->ws + (l == 0 ? WS_W0GU : WS_WGU)) + ((size_t)e * 1024 + pn * 256) * 1024);
            u.o0 = (bf16_t*)(X->ws + WS_ACT) + (size_t)row0 * 512 + pn * 128; u.o1 = nullptr; u.o2 = nullptr; u.ld = 512; }
        else { u.a = (const char*)((const bf16_t*)(X->ws + WS_ACT) + (size_t)row0 * 512); u.b = (const char*)((const bf16_t*)(X->ws + (l == 0 ? WS_W0D : WS_WD)) + ((size_t)e * 1024 + pn * 256) * 512);
            u.o0 = (bf16_t*)(X->ws + WS_YS) + (size_t)row0 * 1024 + pn * 256; u.o1 = nullptr; u.o2 = (const float*)(X->ws + WS_ROUTE + RT_SW) + row0; u.ld = 1024; }
        return true;
    }
};
DI void build_expert_table(const Ctx& X, int l, LAS int* tb) {
    const unsigned* blk = (const unsigned*)(X.ws + WS_CTL) + CW_BLK + l * 8192;
    LAS int* ps = tb + 256;
    { const int e = X.tid & 31, part = X.tid >> 5; int tot = 0, pre = 0;
#pragma unroll 4
      for (int b = part * 16; b < part * 16 + 16; ++b) { const int v = (int)__hip_atomic_load(blk + b * 32 + e, __ATOMIC_RELAXED, __HIP_MEMORY_SCOPE_AGENT); tot += v; pre += (b < X.c) ? v : 0; }
      ps[(part * 2 + 0) * 32 + e] = tot; ps[(part * 2 + 1) * 32 + e] = pre; }
    __syncthreads();
    if (X.tid < 32) { int tot = 0, pre = 0;
        for (int part = 0; part < 16; ++part) { tot += ps[(part * 2 + 0) * 32 + X.tid]; pre += ps[(part * 2 + 1) * 32 + X.tid]; }
        tb[32 + X.tid] = tot; tb[128 + X.tid] = pre; tb[160 + X.tid] = 0; }
    __syncthreads();
    if (X.tid == 0) { int base = 0, tp = 0;
        for (int e = 0; e < 32; ++e) { const int c = tb[32 + e]; tb[e] = base; tb[128 + e] += base; tb[64 + e] = tp; base += c; tp += (c + 255) >> 8; }
        tb[96] = tp; }
    __syncthreads();
}
#define MFMA32(a, b, c) __builtin_amdgcn_mfma_f32_32x32x16_bf16((a), (b), (c), 0, 0, 0)
DI int crow(int reg, int h) { return (reg & 3) + 8 * (reg >> 2) + 4 * h; }
template <class RowMap>
DI void transpose_item(const float* W, int ldw, int K, bf16_t* WT, int k0, int n0, float scale, const RowMap& rowmap, float* scr, int lane) {
    float tv[32];
#pragma unroll
    for (int i = 0; i < 32; ++i) tv[i] = W[(size_t)(k0 + 2 * i + (lane >> 5)) * ldw + n0 + (lane & 31)];
#pragma unroll
    for (int i = 0; i < 32; ++i) scr[(2 * i + (lane >> 5)) * 33 + (lane & 31)] = tv[i];
    asm volatile("s_waitcnt lgkmcnt(0)" ::: "memory");
    const int c = lane & 7;
#pragma unroll
    for (int j = 0; j < 4; ++j) { const int n = (lane >> 3) + 8 * j; const float* s = scr + (8 * c) * 33 + n;
        u32x4 o; o.x = pk2(s[0 * 33] * scale, s[1 * 33] * scale); o.y = pk2(s[2 * 33] * scale, s[3 * 33] * scale); o.z = pk2(s[4 * 33] * scale, s[5 * 33] * scale); o.w = pk2(s[6 * 33] * scale, s[7 * 33] * scale);
        *(u32x4*)(WT + (size_t)rowmap(n0 + n) * K + k0 + 8 * c) = o; }
    asm volatile("s_waitcnt lgkmcnt(0)" ::: "memory");
}
struct RowId { int off; DI int operator()(int n) const { return n + off; } };
struct RowGU { int gu; DI int operator()(int j) const { return 8 * (j >> 2) + 4 * gu + (j & 3); } };

DI void small_weights(const Ctx& X, char* lds, int l, int c_first, int c_count) {
    if (X.c < c_first || X.c >= c_first + c_count) return;
    const int tid = X.tid, lane = tid & 63, wave = tid >> 6; const int gw = (X.c - c_first) * 8 + wave, NGW = c_count * 8;
    __syncthreads();
    { float* scr = (float*)(lds + wave * 8704);
      constexpr int I_WIN = 16 * (PCOLS / 32), I_WB = 8 * 32, I_WO = 16 * 32, I_L = I_WIN + 3 * I_WB + I_WO;
      for (int it = gw; it < I_L; it += NGW) {
          int r = it;
          if (r < I_WIN) { const int kb = r / (PCOLS / 32), nb = r % (PCOLS / 32), n0 = nb * 32; const int o0 = n0 < PC_GATE ? n0 : n0 + 512;
              const float scale = (n0 < PC_KA || (n0 >= PC_KR && n0 < PC_VR)) ? 0.125f : 1.0f;
              transpose_item(X.in(8) + (size_t)l * 1024 * IN_COLS, IN_COLS, 1024, wsmall(X, l, WO_WIN), kb * 64, o0, scale, RowId{n0 - o0}, scr, lane); continue; }
          r -= I_WIN;
          if (r < 3 * I_WB) { const int br = r / I_WB, q = r % I_WB, kb = q / 32, nb = q % 32;
              const float* pb0 = (X.in(12)); const float* pb1 = (X.in(13)); const float* pb2 = (X.in(14));
              transpose_item((br == 0 ? pb0 : br == 1 ? pb1 : pb2) + (size_t)l * 512 * 1024, 1024, 512, wsmall(X, l, br == 0 ? WO_WBA : br == 1 ? WO_WBF : WO_WBR), kb * 64, nb * 32, 1.0f, RowId{0}, scr, lane); continue; }
          r -= 3 * I_WB;
          { const int kb = r / 32, nb = r % 32; transpose_item(X.in(15) + (size_t)l * 1024 * 1024, 1024, 1024, wsmall(X, l, WO_WOUT), kb * 64, nb * 32, 1.0f, RowId{0}, scr, lane); }
      } }
    __syncthreads();
    { float* t128 = (float*)lds;
      float* wt = (float*)(lds + 1024);
      const int fr_ = lane & 15, fq_ = lane >> 4;
      if (tid < 128) { const float rev = (float)tid * (1.0f / 128.0f); t128[tid] = __builtin_amdgcn_cosf(rev) * 0.08838834764831845f; t128[128 + tid] = __builtin_amdgcn_sinf(rev) * 0.08838834764831845f; }
      for (int it = X.c - c_first; it < 4 * 32; it += c_count) {
          const int g = (it >> 5) & 3, k0 = (it & 31) * 32;
          int fr = fr_, fq = fq_; asm volatile("" : "+v"(fr), "+v"(fq));
          __syncthreads();
          { const float* wsrc = X.in(8) + ((size_t)l * 1024 + k0) * IN_COLS + OC_FU + g * 128;
#pragma unroll
            for (int i = 0; i < 2; ++i) { const int e = tid + 512 * i, kk = e >> 5, c4 = e & 31; *(f32x4*)(wt + kk * 132 + 4 * c4) = *(const f32x4*)(wsrc + (size_t)kk * IN_COLS + 4 * c4); } }
          __syncthreads();
          f32x4 acc[2][2];
#pragma unroll
          for (int rt = 0; rt < 2; ++rt)
#pragma unroll
              for (int ct = 0; ct < 2; ++ct) acc[rt][ct] = (f32x4){0.f, 0.f, 0.f, 0.f};
#pragma unroll
          for (int s = 0; s < 4; ++s) {
              bf16x8 af[2], bfr[2];
#pragma unroll
              for (int rt = 0; rt < 2; ++rt) { const int R = 32 * wave + 16 * rt + fr, cs = R >> 7, j = R & 127; const float* T = t128 + cs * 128; float v[8];
#pragma unroll
                  for (int q = 0; q < 8; ++q) v[q] = T[((32 * s + 8 * fq + q) * j) & 127];
                  u32x4 w; w.x = pk2(v[0], v[1]); w.y = pk2(v[2], v[3]); w.z = pk2(v[4], v[5]); w.w = pk2(v[6], v[7]); af[rt] = __builtin_bit_cast(bf16x8, w); }
#pragma unroll
              for (int ct = 0; ct < 2; ++ct) { const float* wp = wt + (16 * ct + fr) * 132 + 32 * s + 8 * fq; const f32x4 w0 = *(const f32x4*)wp, w1 = *(const f32x4*)(wp + 4);
                  u32x4 w; w.x = pk2(w0[0], w0[1]); w.y = pk2(w0[2], w0[3]); w.z = pk2(w1[0], w1[1]); w.w = pk2(w1[2], w1[3]); bfr[ct] = __builtin_bit_cast(bf16x8, w); }
#pragma unroll
              for (int rt = 0; rt < 2; ++rt)
#pragma unroll
                  for (int ct = 0; ct < 2; ++ct) acc[rt][ct] = __builtin_amdgcn_mfma_f32_16x16x32_bf16(af[rt], bfr[ct], acc[rt][ct], 0, 0, 0);
          }
          bf16_t* WF = wsmall(X, l, WO_WF);
#pragma unroll
          for (int rt = 0; rt < 2; ++rt)
#pragma unroll
              for (int ct = 0; ct < 2; ++ct)
#pragma unroll
                  for (int q = 0; q < 4; ++q) { const int R = 32 * wave + 16 * rt + 4 * fq + q, np = (R >> 7) * 512 + g * 128 + (R & 127); WF[(size_t)np * 1024 + k0 + 16 * ct + fr] = f2bf(acc[rt][ct][q]); }
      }
      __syncthreads(); }
}

DI void phase_prologue(const Ctx& X, char* lds) {
    const int tid = X.tid, lane = tid & 63, wave = tid >> 6;
    const int gw = X.c * 8 + wave, NGW = X.G * 8; const int gt = X.c * 512 + tid, NGT = X.G * 512;
    float* tab = (float*)(X.ws + WS_TAB);
    for (int e = gt; e < 512 + 1024 + 65536 + 32; e += NGT) {
        if (e < 512 + 1024 + 65536) {
            int pos, f, nf; float* cdst; float* sdst;
            if (e < 512) { pos = e >> 4; f = e & 15; nf = 16; cdst = tab + TB_ROWC + e; sdst = tab + TB_ROWS + e; }
            else if (e < 1536) { const int q = e - 512; pos = q >> 4; f = q & 15; nf = 16; cdst = tab + TB_COLC + q; sdst = tab + TB_COLS + q; }
            else { const int q = e - 1536; pos = q >> 5; f = q & 31; nf = 32; cdst = tab + TB_RETC + q; sdst = tab + TB_RETS + q; }
            const float inv = exp2f(-(float)f / (float)nf * 13.287712379549449f);
            double s, c; sincos_d((double)((float)pos * inv), s, c); *cdst = (float)c; *sdst = (float)s;
        } else { const int q = e - (512 + 1024 + 65536); const int l = q >> 4, dir = (q >> 3) & 1, hh = q & 7;
            const float* pdf = (X.in(10)); const float* pdb = (X.in(11)); const float xlog = (dir == 0 ? pdf : pdb)[l * 8 + hh];
            const double lg = -log1p(exp(-(double)xlog));
            tab[TB_LG + q] = (float)(lg * 1.4426950408889634); }
    }
    { bf16_t* FN = (bf16_t*)(X.ws + WS_FN); bf16_t* FL = (bf16_t*)(X.ws + WS_FL);
      const int nFN = 2048 * 2048 / 8, nFL = 256 * 512 / 8;
      for (int it = gt; it < nFN + nFL; it += NGT) {
          float v[8]; bf16_t* dst;
          if (it < nFN) { const int k = it >> 8, j0 = (it & 255) * 8; dst = FN + (size_t)k * 2048 + j0; const double sc = 1.0 / sqrt(2048.0), w0 = 6.283185307179586476925 / 2048.0;
#pragma unroll
              for (int j = 0; j < 8; ++j) { const int jj = j0 + j; const bool is_sin = jj > 1024; const int n = is_sin ? jj - 1024 : jj; const int mm = (k * n) & 2047; double s, c; sincos_d(w0 * (double)mm, s, c); v[j] = (float)((is_sin ? -s : c) * sc); } }
          else { const int q = it - nFN, k = q >> 6, n0 = (q & 63) * 8; dst = FL + (size_t)k * 512 + n0; const bool is_sin = n0 >= 256; const int nn0 = is_sin ? n0 - 256 : n0; const double sc = 1.0 / 16.0, w0 = 6.283185307179586476925 / 256.0;
#pragma unroll
              for (int j = 0; j < 8; ++j) { const int mm = (k * (nn0 + j)) & 255; double s, c; sincos_d(w0 * (double)mm, s, c); v[j] = (float)((is_sin ? -s : c) * sc); } }
          u32x4 o; o.x = pk2(v[0], v[1]); o.y = pk2(v[2], v[3]); o.z = pk2(v[4], v[5]); o.w = pk2(v[6], v[7]); *(u32x4*)dst = o; } }
    { float* sv = (float*)lds;
      float* part = (float*)(lds + 36864);
      bool staged = false;
      for (int it = X.c; it < 2 * 96; it += X.G) {
          if (!staged) { for (int e = tid; e < 9 * 1024; e += 512) { const float v = (e < 8192) ? X.in(1)[e] : X.in(3)[e - 8192]; sv[e] = siluf_(v); } staged = true; }
          __syncthreads();
          const int l = it / 96, col = (it % 96) * 64 + lane; const float* W = X.in(6) + (size_t)l * 1024 * 6144;
          float acc[9];
#pragma unroll
          for (int r = 0; r < 9; ++r) acc[r] = 0.f;
          for (int k = wave * 128; k < wave * 128 + 128; ++k) { const float w = W[(size_t)k * 6144 + col];
#pragma unroll
              for (int r = 0; r < 9; ++r) acc[r] += sv[r * 1024 + k] * w; }
#pragma unroll
          for (int r = 0; r < 9; ++r) part[(wave * 9 + r) * 64 + lane] = acc[r];
          __syncthreads();
          for (int e = tid; e < 9 * 64; e += 512) { const int r = e >> 6, cc = e & 63; float s = 0.f;
#pragma unroll
              for (int w8 = 0; w8 < 8; ++w8) s += part[(w8 * 9 + r) * 64 + cc];
              const int cidx = (it % 96) * 64 + cc; ((float*)(X.ws + WS_MODS))[((size_t)(l * 9 + r)) * 6144 + cidx] = s + X.in(7)[l * 6144 + cidx]; }
      }
      __syncthreads(); }
    small_weights(X, lds, 0, 0, X.G);
}

constexpr int N_CONV_ITEMS = 32 * 768;
DI void convert_range(const Ctx& X, int l, char* lds, int item_lo, int item_hi, int c_first, int c_count) {
    if (X.c < c_first || X.c >= c_first + c_count) return;
    const int lane = X.tid & 63, wave = X.tid >> 6; const int gw = (X.c - c_first) * 8 + wave, NGW = c_count * 8;
    float* scr = (float*)(lds + wave * 8704);
    bf16_t* Wgu = (bf16_t*)(X.ws + (l == 0 ? WS_W0GU : WS_WGU)); bf16_t* Wd = (bf16_t*)(X.ws + (l == 0 ? WS_W0D : WS_WD));
    for (int it = item_lo + gw; it < item_hi; it += NGW) {
        int e, r;
        if (l != 0) { e = it / 768; r = it % 768; }
        else if (it < 6144) { e = it / 512; r = it % 512; }
        else if (it < 9216) { const int j = it - 6144; e = j / 256; r = 512 + j % 256; }
        else { const int k = it - 9216; e = 12 + k / 768; r = k % 768; }
        if (r < 512) { const int gu = r >> 8, q = r & 255, kb = q >> 4, nb = q & 15;
            const float* pg0 = (X.in(20)); const float* pg1 = (X.in(21));
            transpose_item((gu == 0 ? pg0 : pg1) + ((size_t)(l * 32 + e)) * 1024 * 512, 512, 1024, Wgu + (size_t)e * 1024 * 1024, kb * 64, nb * 32, 1.0f, RowGU{gu}, scr, lane); }
        else { const int q = r - 512, kb = q >> 5, nb = q & 31;
            transpose_item(X.in(22) + ((size_t)(l * 32 + e)) * 512 * 1024, 1024, 512, Wd + (size_t)e * 1024 * 512, kb * 64, nb * 32, 1.0f, RowId{0}, scr, lane); }
    }
}
constexpr int CV0_P1 = 6144;
constexpr int CV1_A = 7488, CV1_B = 16448;

DI void norm_mod_store(const f32x4 (&v)[4], const float* g, const float* sh, const float* sc, bf16_t* orow, int lane) {
    float ss = 0.f;
#pragma unroll
    for (int j = 0; j < 4; ++j) ss += (v[j].x * v[j].x + v[j].y * v[j].y) + (v[j].z * v[j].z + v[j].w * v[j].w);
    const float rstd = 1.0f / sqrtf(wave_sum(ss, lane) * (1.0f / 1024.0f) + 1e-6f);
#pragma unroll
    for (int j = 0; j < 4; ++j) { const int k = 4 * lane + 256 * j; const f32x4 gg = *(const f32x4*)(g + k), s1 = *(const f32x4*)(sh + k), s2 = *(const f32x4*)(sc + k);
        const f32x4 o = (v[j] * rstd * gg) * (s2 + 1.0f) + s1;
        u32x2 w; w.x = pk2(o.x, o.y); w.y = pk2(o.z, o.w); *(u32x2*)(orow + k) = w; }
}
DI const float* mod_vec(const Ctx& X, int l, int row, int which) { const int bidx = row < R_CTX ? 8 : (row - R_CTX) >> 11; return (const float*)(X.ws + WS_MODS) + ((size_t)(l * 9 + bidx) * 6 + which) * 1024; }

DI void phase_norm0(const Ctx& X) {
    const int lane = X.tid & 63, wave = X.tid >> 6; const int gw = X.c * 8 + wave, NGW = X.G * 8;
    for (int row0 = gw; row0 < R_ALL; row0 += 2 * NGW) {
        f32x4 v[2][4]; int rows[2];
#pragma unroll
        for (int q = 0; q < 2; ++q) { const int row = (row0 + q * NGW < R_ALL) ? row0 + q * NGW : row0; rows[q] = row;
            const float* xr = row < R_CTX ? X.in(2) + (size_t)row * 1024 : X.in(0) + (size_t)(row - R_CTX) * 1024;
#pragma unroll
            for (int j = 0; j < 4; ++j) v[q][j] = *(const f32x4*)(xr + 4 * lane + 256 * j); }
#pragma unroll
        for (int q = 0; q < 2; ++q) if (q == 0 || rows[1] != rows[0]) norm_mod_store(v[q], X.in(4), mod_vec(X, 0, rows[q], 0), mod_vec(X, 0, rows[q], 1), (bf16_t*)(X.ws + WS_H) + (size_t)rows[q] * 1024, lane);
    }
}
DI void phase_combine(const Ctx& X, int l) {
    const int lane = X.tid & 63, wave = X.tid >> 6; const int gw = X.c * 8 + wave, NGW = X.G * 8;
    const bool last = (l == DEPTH - 1); const int row_lo = last ? R_CTX : 0;
    for (int row0 = row_lo + gw; row0 < R_ALL; row0 += 2 * NGW) {
        f32x4 v[2][4]; int rows[2];
        u32x2 xq[2][4], ya[2][4], yb[2][4]; f32x4 gg[2][4];
#pragma unroll
        for (int q = 0; q < 2; ++q) { const int row = (row0 + q * NGW < R_ALL) ? row0 + q * NGW : row0; rows[q] = row;
            const bf16_t* xr = (const bf16_t*)(X.ws + WS_XL) + (size_t)row * 1024; const int* tsl = (const int*)(X.ws + WS_ROUTE + RT_TOKE) + row * 2;
            const bf16_t* y0 = (const bf16_t*)(X.ws + WS_YS) + (size_t)tsl[0] * 1024; const bf16_t* y1 = (const bf16_t*)(X.ws + WS_YS) + (size_t)tsl[1] * 1024;
            const float* g2 = mod_vec(X, l, row, 5);
#pragma unroll
            for (int j = 0; j < 4; ++j) { const int k = 4 * lane + 256 * j; xq[q][j] = *(const u32x2*)(xr + k); gg[q][j] = *(const f32x4*)(g2 + k); ya[q][j] = *(const u32x2*)(y0 + k); yb[q][j] = *(const u32x2*)(y1 + k); } }
#pragma unroll
        for (int q = 0; q < 2; ++q)
#pragma unroll
            for (int j = 0; j < 4; ++j) { const u32x2 a = ya[q][j], b = yb[q][j], xx = xq[q][j]; const f32x4 x = (f32x4){bflo(xx.x), bfhi(xx.x), bflo(xx.y), bfhi(xx.y)};
                f32x4 f; f.x = bflo(a.x) + bflo(b.x); f.y = bfhi(a.x) + bfhi(b.x); f.z = bflo(a.y) + bflo(b.y); f.w = bfhi(a.y) + bfhi(b.y);
                v[q][j] = x + gg[q][j] * f; }
#pragma unroll
        for (int q = 0; q < 2; ++q) if (q == 0 || rows[1] != rows[0]) { const int row = rows[q];
            if (!last) { bf16_t* xr = (bf16_t*)(X.ws + WS_XL) + (size_t)row * 1024;
#pragma unroll
                for (int j = 0; j < 4; ++j) { u32x2 w; w.x = pk2(v[q][j].x, v[q][j].y); w.y = pk2(v[q][j].z, v[q][j].w); *(u32x2*)(xr + 4 * lane + 256 * j) = w; }
                norm_mod_store(v[q], X.in(4) + (l + 1) * 1024, mod_vec(X, l + 1, row, 0), mod_vec(X, l + 1, row, 1), (bf16_t*)(X.ws + WS_H) + (size_t)row * 1024, lane);
            } else {
                float ss = 0.f;
#pragma unroll
                for (int j = 0; j < 4; ++j) ss += (v[q][j].x * v[q][j].x + v[q][j].y * v[q][j].y) + (v[q][j].z * v[q][j].z + v[q][j].w * v[q][j].w);
                const float rstd = 1.0f / sqrtf(wave_sum(ss, lane) * (1.0f / 1024.0f) + 1e-6f);
                float* orow = X.out + (size_t)(row - R_CTX) * 1024;
#pragma unroll
                for (int j = 0; j < 4; ++j) { const int k = 4 * lane + 256 * j; const f32x4 g4 = *(const f32x4*)(X.in(23) + k); *(f32x4*)(orow + k) = v[q][j] * rstd * g4; }
            } }
    }
}

DI void router_planes(const Ctx& X) {
    const int gt = X.c * 512 + X.tid, NGT = X.G * 512;
    bf16_t* wrt = (bf16_t*)(X.ws + WS_WRT);
    for (int e = gt; e < 2 * 64 * 1024; e += NGT) { const int l = e >> 16, col = (e >> 10) & 63, k = e & 1023;
        const float w = col < 4 ? X.in(16)[((size_t)l * 1024 + k) * 4 + col] : col < 36 ? X.in(18)[((size_t)l * 1024 + k) * 32 + (col - 4)] : 0.f;
        const bf16_t hi = f2bf(w); const bf16_t lo = f2bf(w - bf2f(hi));
        wrt[((size_t)((l * 2 + 0) * 64 + col)) * 1024 + k] = hi; wrt[((size_t)((l * 2 + 1) * 64 + col)) * 1024 + k] = lo; }
}
DI void phase_route(const Ctx& X, int l, char* lds) {
    const int tid = X.tid, lane = tid & 63, wave = __builtin_amdgcn_readfirstlane(tid >> 6), r = lane & 31, h = lane >> 5;
    constexpr int HP = 1032;
    bf16_t* Hhi = (bf16_t*)lds; bf16_t* Hlo = Hhi + 32 * HP;
    float* P = (float*)lds;
    float* Lg = (float*)(lds + 2 * 32 * HP * 2);
    int* hist = (int*)(lds + 2 * 32 * HP * 2 + 32 * 36 * 4);
    if (tid < 32) hist[tid] = 0;
    const int row_lo = (l == DEPTH - 1) ? R_CTX : 0, rpb = (R_ALL - row_lo) / X.G;
    const int rpg = (rpb % 24 == 0) ? 3 : 4, GR = 8 * rpg, ng = rpb / GR;
    const bf16_t* wrt = (const bf16_t*)(X.ws + WS_WRT) + (size_t)l * 2 * 64 * 1024;
    int* toke = (int*)(X.ws + WS_ROUTE + RT_TOKE); float* tokw = (float*)(X.ws + WS_ROUTE + RT_TOKW);
    f32x4 gnv[4];
#pragma unroll
    for (int j = 0; j < 4; ++j) gnv[j] = *(const f32x4*)(X.in(5) + l * 1024 + 4 * lane + 256 * j);
    __syncthreads();
#pragma unroll 1
    for (int g = 0; g < ng; ++g) {
        const int rbase = row_lo + X.c * rpb + g * GR;
#pragma unroll 1
        for (int j0 = 0; j0 < rpg; j0 += 2) {
            u32x2 xq[2][4]; f32x4 scv[2][4], shv[2][4]; int rl[2];
#pragma unroll
            for (int q = 0; q < 2; ++q) { const int j = (j0 + q < rpg) ? j0 + q : j0; rl[q] = wave * rpg + j; const int row = rbase + rl[q];
                const bf16_t* xr = (const bf16_t*)(X.ws + WS_XL) + (size_t)row * 1024; const float* sh = mod_vec(X, l, row, 3); const float* sc = mod_vec(X, l, row, 4);
#pragma unroll
                for (int jj = 0; jj < 4; ++jj) { const int k = 4 * lane + 256 * jj; xq[q][jj] = *(const u32x2*)(xr + k); scv[q][jj] = *(const f32x4*)(sc + k); shv[q][jj] = *(const f32x4*)(sh + k); } }
#pragma unroll
            for (int q = 0; q < 2; ++q) if (q == 0 || rl[1] != rl[0]) {
                f32x4 v[4]; float ss = 0.f;
#pragma unroll
                for (int jj = 0; jj < 4; ++jj) { const u32x2 xx = xq[q][jj]; v[jj] = (f32x4){bflo(xx.x), bfhi(xx.x), bflo(xx.y), bfhi(xx.y)}; ss += (v[jj].x * v[jj].x + v[jj].y * v[jj].y) + (v[jj].z * v[jj].z + v[jj].w * v[jj].w); }
                const float rstd = 1.0f / sqrtf(wave_sum(ss, lane) * (1.0f / 1024.0f) + 1e-6f);
                bf16_t* hrow = (bf16_t*)(X.ws + WS_H) + (size_t)(rbase + rl[q]) * 1024;
#pragma unroll
                for (int jj = 0; jj < 4; ++jj) { const int k = 4 * lane + 256 * jj; const f32x4 o = (v[jj] * rstd * gnv[jj]) * (scv[q][jj] + 1.0f) + shv[q][jj];
                    u32x2 hi; hi.x = pk2(o.x, o.y); hi.y = pk2(o.z, o.w);
                    u32x2 lo; lo.x = pk2(o.x - bflo(hi.x), o.y - bfhi(hi.x)); lo.y = pk2(o.z - bflo(hi.y), o.w - bfhi(hi.y));
                    *(u32x2*)(hrow + k) = hi; *(u32x2*)(Hhi + rl[q] * HP + k) = hi; *(u32x2*)(Hlo + rl[q] * HP + k) = lo; } }
        }
        __syncthreads();
        f32x16 acc[2]; float zero = 0.f; asm volatile("" : "+v"(zero));
#pragma unroll
        for (int ct = 0; ct < 2; ++ct)
#pragma unroll
            for (int e = 0; e < 16; ++e) acc[ct][e] = zero;
#pragma unroll 2
        for (int s = 0; s < 8; ++s) { const int kk = 128 * wave + 16 * s + 8 * h;
            const bf16x8 ahi = *(const bf16x8*)(Hhi + r * HP + kk), alo = *(const bf16x8*)(Hlo + r * HP + kk);
#pragma unroll
            for (int ct = 0; ct < 2; ++ct) { const bf16x8 bhi = *(const bf16x8*)(wrt + (size_t)(ct * 32 + r) * 1024 + kk), blo = *(const bf16x8*)(wrt + (size_t)(64 + ct * 32 + r) * 1024 + kk);
                acc[ct] = MFMA32(ahi, bhi, acc[ct]); acc[ct] = MFMA32(alo, bhi, acc[ct]); acc[ct] = MFMA32(ahi, blo, acc[ct]); } }
        __syncthreads();
#pragma unroll
        for (int ct = 0; ct < 2; ++ct)
#pragma unroll
            for (int e = 0; e < 16; ++e) P[(wave * 32 + crow(e, h)) * 64 + ct * 32 + r] = acc[ct][e];
        __syncthreads();
        for (int idx = tid; idx < GR * 36; idx += 512) { const int row = idx / 36, o = idx % 36; float s = 0.f;
#pragma unroll
            for (int w8 = 0; w8 < 8; ++w8) s += P[(w8 * 32 + row) * 64 + o];
            Lg[row * 36 + o] = s + (o < 4 ? X.in(17)[l * 4 + o] : X.in(19)[l * 32 + (o - 4)]); }
        __syncthreads();
        if (tid < GR) { const float* lr = Lg + tid * 36; const int row = rbase + tid;
            int grp = 0; float gm = lr[0];
#pragma unroll
            for (int o = 1; o < 4; ++o) if (lr[o] > gm) { gm = lr[o]; grp = o; }
            float den = 0.f;
#pragma unroll
            for (int o = 0; o < 4; ++o) den += __expf(lr[o] - gm);
            const float pg = 1.0f / den; const float* le = lr + 4 + grp * 8;
            int i0 = 0; float v0 = le[0];
#pragma unroll
            for (int j = 1; j < 8; ++j) if (le[j] > v0) { v0 = le[j]; i0 = j; }
            int i1 = -1; float v1 = -3.0e38f;
#pragma unroll
            for (int j = 0; j < 8; ++j) if (j != i0 && le[j] > v1) { v1 = le[j]; i1 = j; }
            const float w0 = pg / (1.0f + __expf(v1 - v0)), w1 = pg - w0; const int e0 = grp * 8 + i0, e1 = grp * 8 + i1;
            toke[row * 2] = e0; toke[row * 2 + 1] = e1; tokw[row * 2] = w0; tokw[row * 2 + 1] = w1;
            atomicAdd(hist + e0, 1); atomicAdd(hist + e1, 1); }
        __syncthreads();
    }
    if (tid < 32) ((unsigned*)(X.ws + WS_CTL) + CW_BLK + l * 8192)[X.c * 32 + tid] = (unsigned)hist[tid];
}
DI void phase_sortcopy(const Ctx& X, int l, char* lds) {
    const int tid = X.tid, lane = tid & 63, wave = tid >> 6;
    LAS int* tb = (LAS int*)(LAS char*)(lds + LDS_TBL);
    build_expert_table(X, l, tb);
    const int* toke = (const int*)(X.ws + WS_ROUTE + RT_TOKE); const float* tokw = (const float*)(X.ws + WS_ROUTE + RT_TOKW);
    int* sdst = (int*)(X.ws + WS_ROUTE + RT_SDST); float* sw = (float*)(X.ws + WS_ROUTE + RT_SW);
    const int row_lo = (l == DEPTH - 1) ? R_CTX : 0, rpb = (R_ALL - row_lo) / X.G, rpw = rpb / 8;
    const int row0 = row_lo + X.c * rpb + wave * rpw;
    int slot = 0;
    if (lane < 2 * rpw) { const int e = toke[row0 * 2 + lane]; const float w = tokw[row0 * 2 + lane];
        slot = tb[128 + e] + __hip_atomic_fetch_add((LAS int*)(tb + 160 + e), 1, __ATOMIC_RELAXED, __HIP_MEMORY_SCOPE_WORKGROUP);
        sdst[slot] = row0 * 2 + lane; sw[slot] = w; ((int*)toke)[row0 * 2 + lane] = slot; }
}
constexpr float L2E = 1.4426950408889634f;
constexpr int KS_LD = 72, VT_LD = 132, ST_LD = 136;
constexpr int LDS_KS = 0, LDS_VT = 128 * KS_LD * 2, LDS_SL = LDS_VT + 64 * 136 * 2;
DI void unpack8(const u32x4 v, float (&f)[8]) { f[0] = bflo(v.x); f[1] = bfhi(v.x); f[2] = bflo(v.y); f[3] = bfhi(v.y); f[4] = bflo(v.z); f[5] = bfhi(v.z); f[6] = bflo(v.w); f[7] = bfhi(v.w); }
DI u32x4 pack8(const float (&f)[8]) { u32x4 o; o.x = pk2(f[0], f[1]); o.y = pk2(f[2], f[3]); o.z = pk2(f[4], f[5]); o.w = pk2(f[6], f[7]); return o; }
DI void rope8(u32x4& a, u32x4& b, const float* tc, const float* ts) {
    float x1[8], x2[8]; unpack8(a, x1); unpack8(b, x2);
    const f32x4 c0 = *(const f32x4*)tc, c1 = *(const f32x4*)(tc + 4), s0 = *(const f32x4*)ts, s1 = *(const f32x4*)(ts + 4);
    float o1[8], o2[8];
#pragma unroll
    for (int j = 0; j < 8; ++j) { const float c = j < 4 ? c0[j & 3] : c1[j & 3], s = j < 4 ? s0[j & 3] : s1[j & 3]; o1[j] = x1[j] * c - x2[j] * s; o2[j] = x1[j] * s + x2[j] * c; }
    a = pack8(o1); b = pack8(o2);
}
template <int LD = VT_LD>
DI void stage_vt(const bf16_t* proj, int row0, int col0, bf16_t* VT, int tid) {
#pragma unroll
    for (int i = 0; i < 2; ++i) { const int p = tid + 512 * i, key = p >> 3, c8 = p & 7;
        const u32x4 v = *(const u32x4*)(PJ(proj, row0 + key, col0 + 8 * c8));
        bf16_t* d = VT + (8 * c8) * LD + key;
        d[0 * LD] = (bf16_t)(v.x & 0xffff); d[1 * LD] = (bf16_t)(v.x >> 16); d[2 * LD] = (bf16_t)(v.y & 0xffff); d[3 * LD] = (bf16_t)(v.y >> 16);
        d[4 * LD] = (bf16_t)(v.z & 0xffff); d[5 * LD] = (bf16_t)(v.z >> 16); d[6 * LD] = (bf16_t)(v.w & 0xffff); d[7 * LD] = (bf16_t)(v.w >> 16); }
}
DI bf16x8 vt_frag(const bf16_t* VT, int dvrow, int kbase, int h) {
    const u32x2 lo = *(const u32x2*)(VT + dvrow * VT_LD + kbase + 4 * h), hi = *(const u32x2*)(VT + dvrow * VT_LD + kbase + 8 + 4 * h);
    u32x4 w; w.x = lo.x; w.y = lo.y; w.z = hi.x; w.w = hi.y; return __builtin_bit_cast(bf16x8, w);
}

DI void attn_unit(const Ctx& X, int l, char* lds, bool is_ctx, int b, int kvh, int qblk) {
    const int tid = X.tid, lane = tid & 63, wave = __builtin_amdgcn_readfirstlane(tid >> 6), r = lane & 31, h = lane >> 5;
    const int g = wave >> 1, qh = wave & 1, head = kvh * 4 + g;
    const bf16_t* proj = (const bf16_t*)(X.ws + WS_PROJ); const float* tab = (const float*)(X.ws + WS_TAB);
    bf16_t* Ks = (bf16_t*)(lds + LDS_KS); bf16_t* VT = (bf16_t*)(lds + LDS_VT);
    const int qrow0 = is_ctx ? b * 256 + qblk * 128 : R_CTX + b * 2048 + qblk * 128;
    bf16x8 qf[2][4];
#pragma unroll
    for (int qt = 0; qt < 2; ++qt) { const int i = qh * 64 + qt * 32 + r; const bf16_t* qp = PJ(proj, qrow0 + i, PC_QA + head * 64 + 8 * h);
        u32x4 f0 = *(const u32x4*)(qp), f1 = *(const u32x4*)(qp + 16), f2 = *(const u32x4*)(qp + 32), f3 = *(const u32x4*)(qp + 48);
        if (!is_ctx) { const int n = qblk * 128 + i, prow = n >> 6, pcol = n & 63;
            rope8(f0, f1, tab + TB_ROWC + prow * 16 + 8 * h, tab + TB_ROWS + prow * 16 + 8 * h);
            rope8(f2, f3, tab + TB_COLC + pcol * 16 + 8 * h, tab + TB_COLS + pcol * 16 + 8 * h); }
        qf[qt][0] = __builtin_bit_cast(bf16x8, f0); qf[qt][1] = __builtin_bit_cast(bf16x8, f1); qf[qt][2] = __builtin_bit_cast(bf16x8, f2); qf[qt][3] = __builtin_bit_cast(bf16x8, f3); }
    f32x16 O[2][2]; float mrun[2], lsum[2];
#pragma unroll
    for (int qt = 0; qt < 2; ++qt) { mrun[qt] = -1e30f; lsum[qt] = 0.f;
#pragma unroll
        for (int dv = 0; dv < 2; ++dv)
#pragma unroll
            for (int e = 0; e < 16; ++e) O[qt][dv][e] = 0.f; }
    const int nchunk = is_ctx ? 2 : 5;
    u32x4 pka, pkb, pva[2];
    const int skey = tid >> 2, scc = tid & 3, sc = (scc & 1) + 4 * (scc >> 1);
#define ATT_CHUNK(ci_, krow0_, rel_, kblk_, ok_) do { if ((ci_) < 2) { krow0_ = b * 256 + (ci_) * 128; rel_ = 0; kblk_ = 0; ok_ = true; } \
        else { rel_ = (ci_) - 3; kblk_ = qblk + rel_; ok_ = (kblk_ >= 0 && kblk_ < 16); krow0_ = R_CTX + b * 2048 + kblk_ * 128; } } while (0)
#define ATT_ISSUE(ci_) do { int kr_, rl_, kb_; bool ok_; ATT_CHUNK(ci_, kr_, rl_, kb_, ok_); if (ok_) { \
        const bf16_t* kp_ = PJ(proj, kr_ + skey, PC_KA + kvh * 64 + 8 * sc); pka = *(const u32x4*)kp_; pkb = *(const u32x4*)(kp_ + 16); \
        _Pragma("unroll") for (int q_ = 0; q_ < 2; ++q_) { const int p_ = tid + 512 * q_; pva[q_] = *(const u32x4*)(PJ(proj, kr_ + (p_ >> 3), PC_VA + kvh * 64 + 8 * (p_ & 7))); } } } while (0)
    ATT_ISSUE(0);
    for (int ci = 0; ci < nchunk; ++ci) {
        int krow0, rel, kblk; bool okc; ATT_CHUNK(ci, krow0, rel, kblk, okc);
        if (!okc) { continue; }
        __syncthreads();
        { u32x4 a = pka, bq = pkb;
          if (ci >= 2) { const int n = kblk * 128 + skey; const int pos = (sc < 2) ? (n >> 6) : (n & 63);
              rope8(a, bq, tab + ((sc < 2) ? TB_ROWC : TB_COLC) + pos * 16 + 8 * (sc & 1), tab + ((sc < 2) ? TB_ROWS : TB_COLS) + pos * 16 + 8 * (sc & 1)); }
          *(u32x4*)(Ks + skey * KS_LD + 8 * sc) = a; *(u32x4*)(Ks + skey * KS_LD + 8 * sc + 16) = bq;
#pragma unroll
          for (int q = 0; q < 2; ++q) { const int p = tid + 512 * q, key = p >> 3, c8 = p & 7; const u32x4 v = pva[q]; bf16_t* d = VT + (8 * c8) * VT_LD + key;
              d[0 * VT_LD] = (bf16_t)(v.x & 0xffff); d[1 * VT_LD] = (bf16_t)(v.x >> 16); d[2 * VT_LD] = (bf16_t)(v.y & 0xffff); d[3 * VT_LD] = (bf16_t)(v.y >> 16);
              d[4 * VT_LD] = (bf16_t)(v.z & 0xffff); d[5 * VT_LD] = (bf16_t)(v.z >> 16); d[6 * VT_LD] = (bf16_t)(v.w & 0xffff); d[7 * VT_LD] = (bf16_t)(v.w >> 16); } }
        __syncthreads();
        { int nx = ci + 1; if (nx < nchunk) { int kr2, rl2, kb2; bool ok2; ATT_CHUNK(nx, kr2, rl2, kb2, ok2); if (!ok2) nx = nx + 1; } if (nx < nchunk) { ATT_ISSUE(nx); } }
#pragma unroll 1
        for (int kt = 0; kt < 4; ++kt) {
            if ((rel < 0 && qh == 1 && kt < 2) || (rel > 0 && qh == 0 && kt >= 2)) continue;
            f32x16 st[2];
#pragma unroll
            for (int e = 0; e < 16; ++e) { st[0][e] = 0.f; st[1][e] = 0.f; }
            bf16x8 kf[4];
#pragma unroll
            for (int s = 0; s < 4; ++s) kf[s] = *(const bf16x8*)(Ks + (kt * 32 + r) * KS_LD + 16 * s + 8 * h);
#pragma unroll
            for (int s = 0; s < 4; ++s) { st[0] = MFMA32(kf[s], qf[0][s], st[0]); st[1] = MFMA32(kf[s], qf[1][s], st[1]); }
            bf16x8 vfr[2][2];
#pragma unroll
            for (int dv = 0; dv < 2; ++dv)
#pragma unroll
                for (int s2 = 0; s2 < 2; ++s2) vfr[dv][s2] = vt_frag(VT, dv * 32 + r, kt * 32 + 16 * s2, h);
            bf16x8 pb[2][2];
#pragma unroll
            for (int qt = 0; qt < 2; ++qt) {
                const int i = qh * 64 + qt * 32 + r;
                if (rel != 0) {
#pragma unroll
                    for (int e = 0; e < 16; ++e) { const int jj = kt * 32 + crow(e, h); const bool ok = (rel < 0) ? (jj >= i) : (jj <= i); st[qt][e] = ok ? st[qt][e] : -1e30f; } }
                float tmax = st[qt][0];
#pragma unroll
                for (int e = 1; e < 16; ++e) tmax = fmaxf(tmax, st[qt][e]);
                tmax = fmaxf(tmax, shx(tmax, 32, lane));
                const float mnew = fmaxf(mrun[qt], tmax), mb = mnew * L2E;
                if (__any(mnew != mrun[qt])) {
                    const float alpha = fast_exp2((mrun[qt] - mnew) * L2E); lsum[qt] *= alpha;
#pragma unroll
                    for (int dv = 0; dv < 2; ++dv)
#pragma unroll
                        for (int e = 0; e < 16; ++e) O[qt][dv][e] *= alpha; }
                mrun[qt] = mnew;
                float ps = 0.f; float p[16];
#pragma unroll
                for (int e = 0; e < 16; ++e) { p[e] = fast_exp2(st[qt][e] * L2E - mb); ps += p[e]; }
                lsum[qt] += ps;
                u32x4 w0, w1; w0.x = pk2(p[0], p[1]); w0.y = pk2(p[2], p[3]); w0.z = pk2(p[4], p[5]); w0.w = pk2(p[6], p[7]); w1.x = pk2(p[8], p[9]); w1.y = pk2(p[10], p[11]); w1.z = pk2(p[12], p[13]); w1.w = pk2(p[14], p[15]);
                pb[qt][0] = __builtin_bit_cast(bf16x8, w0); pb[qt][1] = __builtin_bit_cast(bf16x8, w1);
            }
#pragma unroll
            for (int dv = 0; dv < 2; ++dv)
#pragma unroll
                for (int s2 = 0; s2 < 2; ++s2) { O[0][dv] = MFMA32(vfr[dv][s2], pb[0][s2], O[0][dv]); O[1][dv] = MFMA32(vfr[dv][s2], pb[1][s2], O[1][dv]); }
        }
    }
#undef ATT_CHUNK
#undef ATT_ISSUE
    const float sink = X.in(9)[l * 8 + head];
    bf16_t* oa = (bf16_t*)(X.ws + WS_OA);
#pragma unroll
    for (int qt = 0; qt < 2; ++qt) { float lt = lsum[qt]; lt += shx(lt, 32, lane); lt += fast_exp2((sink - mrun[qt]) * L2E); const float inv = 1.0f / lt;
        const int i = qh * 64 + qt * 32 + r; bf16_t* op = oa + (size_t)(qrow0 + i) * 512 + head * 64;
#pragma unroll
        for (int dv = 0; dv < 2; ++dv)
#pragma unroll
            for (int rg = 0; rg < 4; ++rg) { u32x2 w; w.x = pk2(O[qt][dv][4 * rg] * inv, O[qt][dv][4 * rg + 1] * inv); w.y = pk2(O[qt][dv][4 * rg + 2] * inv, O[qt][dv][4 * rg + 3] * inv);
                *(u32x2*)(op + dv * 32 + 8 * rg + 4 * h) = w; } }
}

DI void fourier_fold_rows(const Ctx& X, char* lds) {
    const int lane = X.tid & 63, wave = X.tid >> 6; const int gw = X.c * 8 + wave, NGW = X.G * 8;
    bf16_t* sr = (bf16_t*)(lds + wave * 8192);
    for (int row = gw; row < 8 * 512; row += NGW) {
        bf16_t* ut = (bf16_t*)(X.ws + WS_UT) + (size_t)row * 4096;
#pragma unroll
        for (int i = 0; i < 8; ++i) *(u32x4*)(sr + (i * 64 + lane) * 8) = *(const u32x4*)(ut + (i * 64 + lane) * 8);
        asm volatile("s_waitcnt vmcnt(0) lgkmcnt(0)" ::: "memory");
#pragma unroll
        for (int i = 0; i < 4; ++i) { const int j0 = (i * 64 + lane) * 8; float v[8];
#pragma unroll
            for (int t = 0; t < 8; ++t) { const int j = j0 + t; float x;
                if (j == 0 || j == 1024) x = bf2f(sr[j]);
                else if (j < 1024) x = bf2f(sr[j]) + bf2f(sr[2048 - j]);
                else { const int n = j - 1024; x = bf2f(sr[2048 + n]) - bf2f(sr[4096 - n]); }
                v[t] = x; }
            *(u32x4*)(ut + j0) = pack8(v); }
        asm volatile("s_waitcnt lgkmcnt(0)" ::: "memory");
    }
}
DI int ret_row0(int b, int c) { return c < 2 ? b * 256 + c * 128 : R_CTX + b * 2048 + (c - 2) * 128; }
DI void stage_ret_k(const Ctx& X, const bf16_t* proj, int b, int hh, int c, bf16_t* Ks, int tid) {
    const float* tab = (const float*)(X.ws + WS_TAB);
    const int pos = tid >> 2, cc = tid & 3; const bf16_t* kp = PJ(proj, ret_row0(b, c) + pos, PC_KR + hh * 64 + 8 * cc);
    u32x4 a = *(const u32x4*)kp, bq = *(const u32x4*)(kp + 32);
    if (c >= 2) { const int n = (c - 2) * 128 + pos; rope8(a, bq, tab + TB_RETC + n * 32 + 8 * cc, tab + TB_RETS + n * 32 + 8 * cc); }
    *(u32x4*)(Ks + pos * KS_LD + 8 * cc) = a; *(u32x4*)(Ks + pos * KS_LD + 32 + 8 * cc) = bq;
}
struct StLoads { u32x4 a, bq, va[2]; f32x4 c0, c1, s0, s1; };
DI void st_issue(const Ctx& X, StLoads& L, int b, int hh, int c) {
    const int tid = X.tid; const bf16_t* proj = (const bf16_t*)(X.ws + WS_PROJ); const float* tab = (const float*)(X.ws + WS_TAB);
    const int pos = tid >> 2, cc = tid & 3, row0 = ret_row0(b, c); const bf16_t* kp = PJ(proj, row0 + pos, PC_KR + hh * 64 + 8 * cc);
    L.a = *(const u32x4*)kp; L.bq = *(const u32x4*)(kp + 32);
    const int n = (c >= 2) ? (c - 2) * 128 + pos : 0; const float* tc = tab + TB_RETC + n * 32 + 8 * cc; const float* ts = tab + TB_RETS + n * 32 + 8 * cc;
    L.c0 = *(const f32x4*)tc; L.c1 = *(const f32x4*)(tc + 4); L.s0 = *(const f32x4*)ts; L.s1 = *(const f32x4*)(ts + 4);
#pragma unroll
    for (int q = 0; q < 2; ++q) { const int p = tid + 512 * q, key = p >> 3, c8 = p & 7; L.va[q] = *(const u32x4*)(PJ(proj, row0 + key, PC_VR + hh * 64 + 8 * c8)); }
}
DI void ret_state_range(const Ctx& X, int l, char* lds, int u0, int ustride, int ulimit) {
    if (u0 >= ulimit) return;
    const int tid = X.tid, lane = tid & 63, wave = __builtin_amdgcn_readfirstlane(tid >> 6), r = lane & 31, h = lane >> 5;
    const float* tab = (const float*)(X.ws + WS_TAB);
    bf16_t* kfT = (bf16_t*)lds; bf16_t* kbT = kfT + 64 * ST_LD; bf16_t* vT = kbT + 64 * ST_LD;
    StLoads L; st_issue(X, L, u0 / 144, (u0 / 18) & 7, u0 % 18);
#pragma unroll 1
    for (int u = u0; u < ulimit; u += ustride) {
        const int b = u / 144, hh = (u / 18) & 7, c = u % 18;
        const float lgf = tab[TB_LG + l * 16 + hh], lgb = tab[TB_LG + l * 16 + 8 + hh];
        __syncthreads();
        { const int pos = tid >> 2, cc = tid & 3; float k1[8], k2[8]; unpack8(L.a, k1); unpack8(L.bq, k2);
          if (c >= 2) {
#pragma unroll
              for (int j = 0; j < 8; ++j) { const float cv = j < 4 ? L.c0[j & 3] : L.c1[j & 3], sv = j < 4 ? L.s0[j & 3] : L.s1[j & 3]; const float x1 = bf2f(f2bf(k1[j] * cv - k2[j] * sv)), x2 = bf2f(f2bf(k1[j] * sv + k2[j] * cv)); k1[j] = x1; k2[j] = x2; } }
          const float zf = fast_exp2((float)(127 - pos) * lgf), zb = fast_exp2((float)pos * lgb);
#pragma unroll
          for (int j = 0; j < 8; ++j) { kfT[(8 * cc + j) * ST_LD + pos] = f2bf(k1[j] * zf); kfT[(32 + 8 * cc + j) * ST_LD + pos] = f2bf(k2[j] * zf);
              kbT[(8 * cc + j) * ST_LD + pos] = f2bf(k1[j] * zb); kbT[(32 + 8 * cc + j) * ST_LD + pos] = f2bf(k2[j] * zb); }
#pragma unroll
          for (int q = 0; q < 2; ++q) { const int p = tid + 512 * q, key = p >> 3, c8 = p & 7; const u32x4 v = L.va[q]; bf16_t* d = vT + (8 * c8) * ST_LD + key;
              d[0 * ST_LD] = (bf16_t)(v.x & 0xffff); d[1 * ST_LD] = (bf16_t)(v.x >> 16); d[2 * ST_LD] = (bf16_t)(v.y & 0xffff); d[3 * ST_LD] = (bf16_t)(v.y >> 16);
              d[4 * ST_LD] = (bf16_t)(v.z & 0xffff); d[5 * ST_LD] = (bf16_t)(v.z >> 16); d[6 * ST_LD] = (bf16_t)(v.w & 0xffff); d[7 * ST_LD] = (bf16_t)(v.w >> 16); } }
        __syncthreads();
        if (u + ustride < ulimit) { const int u2 = u + ustride; st_issue(X, L, u2 / 144, (u2 / 18) & 7, u2 % 18); }
        const int dir = wave >> 2, dvt = (wave >> 1) & 1, dkt = wave & 1; const bf16_t* kT = dir ? kbT : kfT;
        f32x16 acc;
#pragma unroll
        for (int e = 0; e < 16; ++e) acc[e] = 0.f;
#pragma unroll
        for (int s = 0; s < 8; ++s) { const bf16x8 a = *(const bf16x8*)(vT + (dvt * 32 + r) * ST_LD + 16 * s + 8 * h), bb = *(const bf16x8*)(kT + (dkt * 32 + r) * ST_LD + 16 * s + 8 * h); acc = MFMA32(a, bb, acc); }
        float* U = (float*)(X.ws + WS_H) + ((size_t)(((b * 8 + hh) * 18 + c) * 2 + dir)) * 4096;
#pragma unroll
        for (int e = 0; e < 16; ++e) U[(dvt * 32 + crow(e, h)) * 64 + dkt * 32 + r] = acc[e];
    }
}
DI void ret_scan_unit(const Ctx& X, int l, int b, int hh) {
    const int tid = X.tid; const float* tab = (const float*)(X.ws + WS_TAB);
    const float g128f = fast_exp2(128.0f * tab[TB_LG + l * 16 + hh]), g128b = fast_exp2(128.0f * tab[TB_LG + l * 16 + 8 + hh]);
    const float* U = (const float*)(X.ws + WS_H) + (size_t)(b * 8 + hh) * 36 * 4096; bf16_t* S = (bf16_t*)(X.ws + WS_SST) + (size_t)(b * 8 + hh) * 36 * 4096;
    const int e0 = tid * 8;
#define UL(c, dir, j) U[((c) * 2 + (dir)) * 4096 + e0 + (j)]
#define SS(c, dir) (S + ((c) * 2 + (dir)) * 4096 + e0)
    float st[8], z[8];
#pragma unroll
    for (int j = 0; j < 8; ++j) z[j] = 0.f;
#pragma unroll
    for (int j = 0; j < 8; ++j) st[j] = UL(0, 0, j);
    { u32x4 zz = {0u, 0u, 0u, 0u}; asm volatile("" : "+v"(zz)); *(u32x4*)SS(0, 0) = zz; } *(u32x4*)SS(1, 0) = pack8(st);
#pragma unroll
    for (int j = 0; j < 8; ++j) st[j] = g128f * st[j] + UL(1, 0, j);
    for (int c = 2; c < 18; ++c) { *(u32x4*)SS(c, 0) = pack8(st);
#pragma unroll
        for (int j = 0; j < 8; ++j) st[j] = g128f * st[j] + UL(c, 0, j); }
#pragma unroll
    for (int j = 0; j < 8; ++j) st[j] = UL(1, 1, j);
    { u32x4 zz = {0u, 0u, 0u, 0u}; asm volatile("" : "+v"(zz)); *(u32x4*)SS(1, 1) = zz; } *(u32x4*)SS(0, 1) = pack8(st);
#pragma unroll
    for (int j = 0; j < 8; ++j) st[j] = UL(0, 1, j) + g128b * st[j];
    for (int c = 17; c >= 2; --c) { *(u32x4*)SS(c, 1) = pack8(st);
#pragma unroll
        for (int j = 0; j < 8; ++j) st[j] = g128b * st[j] + UL(c, 1, j); }
#undef UL
#undef SS
}
DI unsigned* ret_flag(const Ctx& X, int l, int b, int hh) { return (unsigned*)(X.ws + WS_CTL) + CW_FLAG + ((l * 64 + b * 8 + hh) * 64); }
DI void ret_scan_publish(const Ctx& X, int l, int b, int hh) {
    asm volatile("s_waitcnt vmcnt(0)" ::: "memory");
    __syncthreads();
    if (X.tid == 0) { __builtin_amdgcn_fence(__ATOMIC_RELEASE, "agent"); asm volatile("s_waitcnt vmcnt(0)" ::: "memory");
        __hip_atomic_store(ret_flag(X, l, b, hh), 1u, __ATOMIC_RELAXED, __HIP_MEMORY_SCOPE_AGENT); }
}
DI void ret_scan_wait_all(const Ctx& X, int l) {
    if (X.tid < 64) { unsigned* f = ret_flag(X, l, X.tid >> 3, X.tid & 7); unsigned sp = 0;
        while (__hip_atomic_load(f, __ATOMIC_RELAXED, __HIP_MEMORY_SCOPE_AGENT) == 0u) { __builtin_amdgcn_s_sleep(2); if (++sp > (1u << 22)) break; }
        __builtin_amdgcn_fence(__ATOMIC_ACQUIRE, "agent"); asm volatile("s_waitcnt vmcnt(0)" ::: "memory"); }
    __syncthreads();
}
struct RoLoads { u32x4 ka, kb2, va[2]; f32x4 kc0, kc1, ks0, ks1; u32x4 sst[2]; u32x4 f0, f1, f2, f3; };
DI void ro_issue(const Ctx& X, RoLoads& L, int b, int hh, int c) {
    const int tid = X.tid, lane = tid & 63, wave = tid >> 6, r = lane & 31, h = lane >> 5;
    const bf16_t* proj = (const bf16_t*)(X.ws + WS_PROJ); const float* tab = (const float*)(X.ws + WS_TAB);
    const int row0 = ret_row0(b, c), i = (wave & 3) * 32 + r;
    { const int pos = tid >> 2, cc = tid & 3; const bf16_t* kp = PJ(proj, row0 + pos, PC_KR + hh * 64 + 8 * cc); L.ka = *(const u32x4*)kp; L.kb2 = *(const u32x4*)(kp + 32);
      const int n = (c >= 2) ? (c - 2) * 128 + pos : 0; const float* tc = tab + TB_RETC + n * 32 + 8 * cc; const float* ts = tab + TB_RETS + n * 32 + 8 * cc;
      L.kc0 = *(const f32x4*)tc; L.kc1 = *(const f32x4*)(tc + 4); L.ks0 = *(const f32x4*)ts; L.ks1 = *(const f32x4*)(ts + 4);
#pragma unroll
      for (int q = 0; q < 2; ++q) { const int p = tid + 512 * q, key = p >> 3, c8 = p & 7; L.va[q] = *(const u32x4*)(PJ(proj, row0 + key, PC_VR + hh * 64 + 8 * c8)); } }
    { const bf16_t* S = (const bf16_t*)(X.ws + WS_SST) + ((size_t)((b * 8 + hh) * 18 + c)) * 2 * 4096;
#pragma unroll
      for (int q = 0; q < 2; ++q) L.sst[q] = *(const u32x4*)(S + (size_t)(tid + 512 * q) * 8); }
    { const bf16_t* qp = PJ(proj, row0 + i, PC_QR + hh * 64 + 8 * h);
      L.f0 = *(const u32x4*)(qp); L.f1 = *(const u32x4*)(qp + 16); L.f2 = *(const u32x4*)(qp + 32); L.f3 = *(const u32x4*)(qp + 48); }
}
DI void ret_out_range(const Ctx& X, int l, char* lds, int u0, int ustride, int ucount, int nc, int c0) {
    if (ucount <= 0) return;
    const int tid = X.tid, lane = tid & 63, wave = __builtin_amdgcn_readfirstlane(tid >> 6), r = lane & 31, h = lane >> 5;
    const bf16_t* proj = (const bf16_t*)(X.ws + WS_PROJ); const float* tab = (const float*)(X.ws + WS_TAB);
    bf16_t* Ks = (bf16_t*)(lds + LDS_KS); bf16_t* VT = (bf16_t*)(lds + LDS_VT); bf16_t* SL = (bf16_t*)(lds + LDS_SL);
    const int i = (wave & 3) * 32 + r;
    RoLoads L;
    ro_issue(X, L, (u0 / nc) >> 3, (u0 / nc) & 7, c0 + u0 % nc);
#pragma unroll 1
    for (int k = 0; k < ucount; ++k) {
        const int u = u0 + k * ustride, b = (u / nc) >> 3, hh = (u / nc) & 7, c = c0 + u % nc;
        const float lgf = tab[TB_LG + l * 16 + hh], lgb = tab[TB_LG + l * 16 + 8 + hh];
        const int row0 = ret_row0(b, c);
        u32x2 gg[2][4]; f32x4 qc[4], qs[4];
        { const int n = (c >= 2) ? (c - 2) * 128 + i : 0; const float* tc = tab + TB_RETC + n * 32 + 8 * h; const float* ts = tab + TB_RETS + n * 32 + 8 * h;
          qc[0] = *(const f32x4*)tc; qc[1] = *(const f32x4*)(tc + 4); qc[2] = *(const f32x4*)(tc + 16); qc[3] = *(const f32x4*)(tc + 20);
          qs[0] = *(const f32x4*)ts; qs[1] = *(const f32x4*)(ts + 4); qs[2] = *(const f32x4*)(ts + 16); qs[3] = *(const f32x4*)(ts + 20); }
        if (wave < 4) { const bf16_t* gp = PJ(proj, row0 + i, PC_GR + hh * 64);
#pragma unroll
            for (int dv = 0; dv < 2; ++dv)
#pragma unroll
                for (int rg = 0; rg < 4; ++rg) gg[dv][rg] = *(const u32x2*)(gp + dv * 32 + 8 * rg + 4 * h); }
        __syncthreads();
        { const int pos = tid >> 2, cc = tid & 3; u32x4 ka = L.ka, kb2 = L.kb2;
          if (c >= 2) { float x1[8], x2[8], o1[8], o2[8]; unpack8(ka, x1); unpack8(kb2, x2);
#pragma unroll
              for (int j = 0; j < 8; ++j) { const float cv = j < 4 ? L.kc0[j & 3] : L.kc1[j & 3], sv = j < 4 ? L.ks0[j & 3] : L.ks1[j & 3]; o1[j] = x1[j] * cv - x2[j] * sv; o2[j] = x1[j] * sv + x2[j] * cv; }
              ka = pack8(o1); kb2 = pack8(o2); }
          *(u32x4*)(Ks + pos * KS_LD + 8 * cc) = ka; *(u32x4*)(Ks + pos * KS_LD + 32 + 8 * cc) = kb2;
#pragma unroll
          for (int q = 0; q < 2; ++q) { const int p = tid + 512 * q, key = p >> 3, c8 = p & 7; const u32x4 v = L.va[q]; bf16_t* d = VT + (8 * c8) * VT_LD + key;
              d[0 * VT_LD] = (bf16_t)(v.x & 0xffff); d[1 * VT_LD] = (bf16_t)(v.x >> 16); d[2 * VT_LD] = (bf16_t)(v.y & 0xffff); d[3 * VT_LD] = (bf16_t)(v.y >> 16);
              d[4 * VT_LD] = (bf16_t)(v.z & 0xffff); d[5 * VT_LD] = (bf16_t)(v.z >> 16); d[6 * VT_LD] = (bf16_t)(v.w & 0xffff); d[7 * VT_LD] = (bf16_t)(v.w >> 16); }
#pragma unroll
          for (int q = 0; q < 2; ++q) { const int e = tid + 512 * q, rowi = e >> 3, ch = e & 7; *(u32x4*)(SL + rowi * KS_LD + 8 * ch) = L.sst[q]; } }
        bf16x8 qf[4];
        { u32x4 f0 = L.f0, f1 = L.f1, f2 = L.f2, f3 = L.f3;
          if (c >= 2) { float x1[8], x2[8], o1[8], o2[8];
              unpack8(f0, x1); unpack8(f2, x2);
#pragma unroll
              for (int j = 0; j < 8; ++j) { const float cv = j < 4 ? qc[0][j & 3] : qc[1][j & 3], sv = j < 4 ? qs[0][j & 3] : qs[1][j & 3]; o1[j] = x1[j] * cv - x2[j] * sv; o2[j] = x1[j] * sv + x2[j] * cv; }
              f0 = pack8(o1); f2 = pack8(o2);
              unpack8(f1, x1); unpack8(f3, x2);
#pragma unroll
              for (int j = 0; j < 8; ++j) { const float cv = j < 4 ? qc[2][j & 3] : qc[3][j & 3], sv = j < 4 ? qs[2][j & 3] : qs[3][j & 3]; o1[j] = x1[j] * cv - x2[j] * sv; o2[j] = x1[j] * sv + x2[j] * cv; }
              f1 = pack8(o1); f3 = pack8(o2); }
          qf[0] = __builtin_bit_cast(bf16x8, f0); qf[1] = __builtin_bit_cast(bf16x8, f1); qf[2] = __builtin_bit_cast(bf16x8, f2); qf[3] = __builtin_bit_cast(bf16x8, f3); }
        __syncthreads();
        if (k + 1 < ucount) { const int u2 = u + ustride; ro_issue(X, L, (u2 / nc) >> 3, (u2 / nc) & 7, c0 + u2 % nc); }
        if (wave < 4) {
            f32x16 O[2];
#pragma unroll
            for (int dv = 0; dv < 2; ++dv)
#pragma unroll
                for (int e = 0; e < 16; ++e) O[dv][e] = 0.f;
#pragma unroll 1
            for (int kt = 0; kt < 4; ++kt) {
                f32x16 st;
#pragma unroll
                for (int e = 0; e < 16; ++e) st[e] = 0.f;
#pragma unroll
                for (int s = 0; s < 4; ++s) st = MFMA32(*(const bf16x8*)(Ks + (kt * 32 + r) * KS_LD + 16 * s + 8 * h), qf[s], st);
                float p[16];
#pragma unroll
                for (int e = 0; e < 16; ++e) { const int d = i - (kt * 32 + crow(e, h)); p[e] = st[e] * (d >= 0 ? fast_exp2((float)d * lgf) : fast_exp2((float)(-d) * lgb)); }
                u32x4 w0, w1; w0.x = pk2(p[0], p[1]); w0.y = pk2(p[2], p[3]); w0.z = pk2(p[4], p[5]); w0.w = pk2(p[6], p[7]); w1.x = pk2(p[8], p[9]); w1.y = pk2(p[10], p[11]); w1.z = pk2(p[12], p[13]); w1.w = pk2(p[14], p[15]);
                const bf16x8 pb0 = __builtin_bit_cast(bf16x8, w0), pb1 = __builtin_bit_cast(bf16x8, w1);
#pragma unroll
                for (int dv = 0; dv < 2; ++dv) { O[dv] = MFMA32(vt_frag(VT, dv * 32 + r, kt * 32, h), pb0, O[dv]); O[dv] = MFMA32(vt_frag(VT, dv * 32 + r, kt * 32 + 16, h), pb1, O[dv]); }
            }
            const float xif = fast_exp2((float)(i + 1) * lgf), xib = fast_exp2((float)(128 - i) * lgb);
#pragma unroll
            for (int dv = 0; dv < 2; ++dv) { f32x16 cf, cb;
#pragma unroll
                for (int e = 0; e < 16; ++e) { cf[e] = 0.f; cb[e] = 0.f; }
#pragma unroll
                for (int s = 0; s < 4; ++s) { cf = MFMA32(*(const bf16x8*)(SL + (dv * 32 + r) * KS_LD + 16 * s + 8 * h), qf[s], cf); cb = MFMA32(*(const bf16x8*)(SL + (64 + dv * 32 + r) * KS_LD + 16 * s + 8 * h), qf[s], cb); }
#pragma unroll
                for (int e = 0; e < 16; ++e) O[dv][e] += xif * cf[e] + xib * cb[e]; }
            float sm = 0.f;
#pragma unroll
            for (int dv = 0; dv < 2; ++dv)
#pragma unroll
                for (int e = 0; e < 16; ++e) sm += O[dv][e];
            sm += shx(sm, 32, lane); const float mu = sm * (1.0f / 64.0f);
            float sq = 0.f;
#pragma unroll
            for (int dv = 0; dv < 2; ++dv)
#pragma unroll
                for (int e = 0; e < 16; ++e) { const float d = O[dv][e] - mu; sq += d * d; }
            sq += shx(sq, 32, lane); const float rs = 1.0f / sqrtf(sq * (1.0f / 64.0f) + 1e-5f);
            bf16_t* op = (bf16_t*)(X.ws + WS_RET) + (size_t)(row0 + i) * 512 + hh * 64;
#pragma unroll
            for (int dv = 0; dv < 2; ++dv)
#pragma unroll
                for (int rg = 0; rg < 4; ++rg) { const int d0 = dv * 32 + 8 * rg + 4 * h; const u32x2 g2 = gg[dv][rg];
                    const float o0 = siluf_(bflo(g2.x)) * (O[dv][4 * rg] - mu) * rs, o1 = siluf_(bfhi(g2.x)) * (O[dv][4 * rg + 1] - mu) * rs, o2 = siluf_(bflo(g2.y)) * (O[dv][4 * rg + 2] - mu) * rs, o3 = siluf_(bfhi(g2.y)) * (O[dv][4 * rg + 3] - mu) * rs;
                    u32x2 w; w.x = pk2(o0, o1); w.y = pk2(o2, o3); *(u32x2*)(op + d0) = w; }
        }
    }
}
#define XB_TMO      128
#define XB_XCNT(j)  (256  + 64 * (j))
#define XB_XSUB(j)  (1280 + 64 * (j))
#define XB_XGEN(j)  (2304 + 64 * (j))
#define XB_TOP      3328
#define XB_TOPGEN   3392
#define XCD_BAR_WORDS 3456
#define XB_SPIN_CAP (1u << 18)
DI unsigned xb_ld(unsigned* p)              { return __hip_atomic_load(p, __ATOMIC_RELAXED, __HIP_MEMORY_SCOPE_AGENT); }
DI unsigned xb_add(unsigned* p, unsigned v) { return __hip_atomic_fetch_add(p, v, __ATOMIC_RELAXED, __HIP_MEMORY_SCOPE_AGENT); }
DI unsigned xb_xcc_id() { return (unsigned)__builtin_amdgcn_s_getreg((3 << 11) | 20) & 0xFu; }
#define XB_SPIN(cond, bar) do { unsigned _sp = 0; while (cond) { __builtin_amdgcn_s_sleep(1); \
    if ((++_sp & 255u) == 0u) { if (xb_ld(&(bar)[XB_TMO])) break; if (_sp > XB_SPIN_CAP) { atomicAdd(&(bar)[XB_TMO], 1u); break; } } } } while (0)
struct XcdBarrier { unsigned* bar; unsigned x; volatile LAS unsigned* st; };
DI XcdBarrier xcd_barrier_post(unsigned* bar, volatile LAS unsigned* st) {
    XcdBarrier b; b.bar = bar; b.x = xb_xcc_id(); b.st = st;
    if (threadIdx.x == 0) (void)xb_add(&bar[XB_XCNT(b.x)], 1u);
    return b;
}
DI void xcd_barrier_complete(unsigned* bar, unsigned x, unsigned& nloc, unsigned& nx) {
    const unsigned G = gridDim.x * gridDim.y * gridDim.z;
    unsigned sum, cnt, mine, sp = 0u;
    for (;;) {
        sum = 0u; cnt = 0u; mine = 0u;
#pragma unroll
        for (unsigned j = 0; j < 16; ++j) { const unsigned c = xb_ld(&bar[XB_XCNT(j)]); sum += c; cnt += (c > 0u) ? 1u : 0u; mine = (j == x) ? c : mine; }
        if (sum == G) break;
        __builtin_amdgcn_s_sleep(1);
        if ((++sp & 255u) == 0u) { if (xb_ld(&bar[XB_TMO])) break; if (sp > XB_SPIN_CAP) { atomicAdd(&bar[XB_TMO], 1u); break; } }
    }
    nloc = mine > 0u ? mine : 1u; nx = cnt > 0u ? cnt : 1u;
}
DI void xcd_barrier(const XcdBarrier& b, const int tid) {
    asm volatile("s_waitcnt vmcnt(0)" ::: "memory");
    __syncthreads();
    if (tid == 0) {
        unsigned* bar = b.bar;
        __builtin_amdgcn_s_waitcnt(0);
        unsigned nloc = b.st[0], nx = b.st[1];
        if (nloc == 0u) { xcd_barrier_complete(bar, b.x, nloc, nx); b.st[0] = nloc; b.st[1] = nx; }
        const unsigned old = xb_add(&bar[XB_XSUB(b.x)], 1u);
        const unsigned gen = old / nloc;
        if (old + 1u == (gen + 1u) * nloc) {
            __builtin_amdgcn_fence(__ATOMIC_RELEASE, "agent");
            asm volatile("s_waitcnt vmcnt(0)" ::: "memory");
            const unsigned og = xb_add(&bar[XB_TOP], 1u);
            const unsigned tg = og / nx;
            if (og + 1u == (tg + 1u) * nx) xb_add(&bar[XB_TOPGEN], 1u);
            else XB_SPIN(xb_ld(&bar[XB_TOPGEN]) == tg, bar);
            __builtin_amdgcn_fence(__ATOMIC_ACQUIRE, "agent");
            xb_add(&bar[XB_XGEN(b.x)], 1u);
            asm volatile("s_waitcnt vmcnt(0)" ::: "memory");
        } else {
            XB_SPIN(xb_ld(&bar[XB_XGEN(b.x)]) == gen, bar);
            __builtin_amdgcn_fence(__ATOMIC_ACQUIRE, "agent");
            asm volatile("s_waitcnt vmcnt(0)" ::: "memory");
        }
    }
    __syncthreads();
}
constexpr int N_PHASES = 20;

DI void run_phase(const Ctx& X, int ph, unsigned char* lds_raw) {
    char* lds = (char*)lds_raw; LAS unsigned char* ldsL = (LAS unsigned char*)lds_raw;
#ifndef ONLY
#define ONLY -1
#endif
#define EN(k) (ONLY < 0 || ONLY == (k))
    if (ph == 0) { if constexpr (EN(100)) phase_prologue(X, lds); return; }
    if (ph == 1) { if constexpr (EN(101)) { router_planes(X); phase_norm0(X); convert_range(X, 0, lds, 0, CV0_P1, 0, X.G); } return; }
    const int l = (ph - 2) / 9, sub0 = (ph - 2) % 9, sub = sub0 < 3 ? sub0 : (sub0 == 3 ? 4 : sub0 + 2);
    switch (sub) {
    case 0: if constexpr (EN(0)) {
        if (l == 0) { convert_range(X, 1, lds, 0, CV1_A / 2, 152, 104); __syncthreads(); }
        { SchedA S; S.init(&X, l); EpiStore E; pg8::gemm_phase<EpiStore, SchedA, true, true>(ldsL, 1024, S, E, X.tid); }
        if (l == 0) { unsigned char* lr = lds_raw; asm volatile("" : "+s"(lr)); convert_range(X, 1, (char*)lr, CV1_A / 2, CV1_A, 152, 104); }
#ifdef REP_A_NOEPI
        { __syncthreads(); SchedA S; S.init(&X, l); EpiNone E; pg8::gemm_phase<EpiNone, SchedA, true, true>(ldsL, 1024, S, E, X.tid); }
#endif
    } break;
    case 1: if constexpr (EN(1)) { {
#ifndef REP_ATTN
#define REP_ATTN 1
#endif
#ifndef REP_STATE
#define REP_STATE 1
#endif
        fourier_fold_rows(X, lds); __syncthreads();
        for (int rep = 0; rep < REP_ATTN; ++rep)
        for (int u = X.c; u < 256; u += X.G) attn_unit(X, l, lds, false, u >> 5, (u >> 4) & 1, u & 15);
        if (l == 0) for (int u = X.G - 1 - X.c; u < 32; u += X.G) attn_unit(X, l, lds, true, u >> 2, (u >> 1) & 1, u & 1);
        ret_state_range(X, l, lds, X.c, X.G, 8 * 8 * 18);
        if (l == 0) { __syncthreads(); convert_range(X, 1, lds, CV1_A, CV1_B, 0, 224); }
    } } break;
    case 2: if constexpr (EN(2)) { {
        { SchedF2 S; S.X = &X; EpiStore E; pg8::gemm_phase<EpiStore, SchedF2, false, true>(ldsL, 2048, S, E, X.tid, 2048, 4096); }
        if (l == 0) { SchedF2c S; S.X = &X; EpiStore E; pg8::gemm_phase<EpiStore, SchedF2c, false, true>(ldsL, 512, S, E, X.tid); }
        if (X.c >= 192) { const int u = X.c - 192; ret_scan_unit(X, l, u >> 3, u & 7); ret_scan_publish(X, l, u >> 3, u & 7); }
        { const int nc = (l == 0) ? 18 : 16, c0 = (l == 0) ? 0 : 2, NU = 64 * nc;
          ret_scan_wait_all(X, l);
#ifndef REP_RETOUT
#define REP_RETOUT 1
#endif
          if (X.c >= 128) ret_out_range(X, l, lds, X.c - 128, 128, 6, nc, c0);
          else ret_out_range(X, l, lds, 768 + X.c, 128, (NU - 768 - X.c + 127) / 128, nc, c0); }
    } } break;
    case 4: if constexpr (EN(4)) { { SchedM S; S.init(&X, l); EpiMerge E; pg8::gemm_phase<EpiMerge, SchedM, true, true>(ldsL, 512, S, E, X.tid); }
        merge_publish(X, l);
        { SchedO S; S.init(&X, l); out_wait(X, S); EpiOut E; pg8::gemm_phase<EpiOut, SchedO, true, true>(ldsL, 1024, S, E, X.tid); }
        if (l == 0) convert_range(X, 0, lds, CV0_P1, N_CONV_ITEMS, 96, 160); } break;
    case 6: if constexpr (EN(6)) { phase_route(X, l, lds); } break;
    case 7: if constexpr (EN(7)) { phase_sortcopy(X, l, lds); } break;
    case 8: if constexpr (EN(8)) { { LAS int* tb = (LAS int*)(ldsL + LDS_TBL); build_expert_table(X, l, tb); SchedE S; S.X = &X; S.tb = tb; S.which = 1; S.l = l; EpiGU E;
        const int rem1 = (l == 0) ? (tb[96] * 4) % X.G : 0; constexpr int CVH = (CV1_B + N_CONV_ITEMS) / 2;
        if (rem1 != 0) { convert_range(X, 1, lds, CV1_B, CVH, rem1, X.G - rem1); __syncthreads(); }
        pg8::gemm_phase<EpiGU, SchedE, true, true, true>(ldsL, 1024, S, E, X.tid);
        if (rem1 != 0) { unsigned char* lr = lds_raw; asm volatile("" : "+s"(lr)); __syncthreads(); convert_range(X, 1, (char*)lr, CVH, N_CONV_ITEMS, rem1, X.G - rem1); } } } break;
    case 9: if constexpr (EN(9)) { { LAS int* tb = (LAS int*)(ldsL + LDS_TBL); build_expert_table(X, l, tb); SchedE S; S.X = &X; S.tb = tb; S.which = 2; S.l = l; EpiDown E; pg8::gemm_phase<EpiDown, SchedE, true, true>(ldsL, 512, S, E, X.tid);
        if (l == 0) { const int rem = (tb[96] * 4) % X.G; if (rem != 0) { unsigned char* lr = lds_raw; asm volatile("" : "+s"(lr)); small_weights(X, (char*)lr, 1, rem, X.G - rem); } } } } break;
    case 10: if constexpr (EN(10)) { { phase_combine(X, l); if (l == 0) { LAS int* tb = (LAS int*)(ldsL + LDS_TBL); build_expert_table(X, 0, tb); if ((tb[96] * 4) % X.G == 0) { convert_range(X, 1, lds, CV1_B, N_CONV_ITEMS, 0, X.G); small_weights(X, lds, 1, 0, X.G); } } } } break;
    }
}

__global__ void __launch_bounds__(512, 2) fwd_kernel(Params p) {
    extern __shared__ __attribute__((aligned(16))) unsigned char lds_raw[];
    const int wave_s = __builtin_amdgcn_readfirstlane((int)threadIdx.x >> 6);
    volatile LAS unsigned* bst = (volatile LAS unsigned*)((LAS unsigned char*)lds_raw + LDS_BYTES - 64);
    if (threadIdx.x < 2) bst[threadIdx.x] = 0u;
    __syncthreads();
    if (p.ph_hi < 0) cg::this_grid().sync();
    XcdBarrier xbar; xbar.bar = nullptr; xbar.x = 0; xbar.st = bst;
    if (p.ph_hi - p.ph_lo > 1) xbar = xcd_barrier_post((unsigned*)(p.ws + WS_CTL) + CW_BAR, bst);
#define SEAM(k) do { { unsigned am2_ = ~0u; asm volatile("" : "+s"(am2_)); const int t2_ = wave_s * 64 + (int)__builtin_amdgcn_mbcnt_hi(am2_, __builtin_amdgcn_mbcnt_lo(am2_, 0u)); xcd_barrier(xbar, t2_); } } while (0)
#define MAKE_CTX(X) Ctx X; { unsigned am_ = ~0u; asm volatile("" : "+s"(am_)); int t = wave_s * 64 + (int)__builtin_amdgcn_mbcnt_hi(am_, __builtin_amdgcn_mbcnt_lo(am_, 0u)), c = blockIdx.x; KParams kp = (KParams)__builtin_amdgcn_kernarg_segment_ptr(); asm volatile("" : "+v"(t), "+s"(c), "+s"(kp)); X.tid = t; X.c = c; X.P = kp; } X.out = X.P->out; X.ws = X.P->ws; X.G = gridDim.x;
    if (p.ph_lo <= 0 && 0 < p.ph_hi) { MAKE_CTX(X); run_phase(X, 0, lds_raw); if (1 < p.ph_hi) SEAM(0); }
    if (p.ph_lo <= 1 && 1 < p.ph_hi) { MAKE_CTX(X); run_phase(X, 1, lds_raw); if (2 < p.ph_hi) SEAM(1); }
    for (int ph = p.ph_lo < 2 ? 2 : p.ph_lo; ph < p.ph_hi; ++ph) {
        MAKE_CTX(X);
        run_phase(X, ph, lds_raw);
        if (ph + 1 < p.ph_hi) SEAM(ph);
    }
}

extern "C" void kernel_launch(void* const* d_in, const int* in_sizes, int n_in, void* d_out, int out_size, void* d_ws, size_t ws_size, hipStream_t stream) {
    static int grid = 0;
    if (grid == 0) {
        if (n_in != 24 || out_size != R_LAT * D || ws_size < WS_END2) { fprintf(stderr, "kernel_launch: unexpected problem (n_in %d, out %d, ws %zu < %zu)\n", n_in, out_size, ws_size, (size_t)WS_END2); grid = -1; return; }
        if (hipFuncSetAttribute((const void*)fwd_kernel, hipFuncAttributeMaxDynamicSharedMemorySize, LDS_BYTES) != hipSuccess) { fprintf(stderr, "kernel_launch: hipFuncSetAttribute failed\n"); grid = -1; return; }
        int dev = 0, cus = 0, per_cu = 0; hipGetDevice(&dev); hipDeviceGetAttribute(&cus, hipDeviceAttributeMultiprocessorCount, dev);
        hipOccupancyMaxActiveBlocksPerMultiprocessor(&per_cu, (const void*)fwd_kernel, 512, LDS_BYTES);
        (void)hipGetLastError();
        if (cus != 256 || per_cu < 1) { fprintf(stderr, "kernel_launch: needs 256 CUs with one resident workgroup each (cus %d, per_cu %d)\n", cus, per_cu); }
        grid = 256;
    }
    if (grid < 0) return;
    hipMemsetAsync((char*)d_ws + WS_CTL, 0, CTL_BYTES, stream);
    Params p{};
    for (int i = 0; i < 24; ++i) p.in[i] = (const float*)d_in[i];
    p.out = (float*)d_out; p.ws = (unsigned char*)d_ws;
#if MK_LAUNCHES == 1
    p.ph_lo = 0; p.ph_hi = N_PHASES;
    void* args[] = {&p};
    hipError_t e = hipLaunchCooperativeKernel((const void*)fwd_kernel, dim3(grid), dim3(512), args, LDS_BYTES, stream);
    if (e != hipSuccess) fprintf(stderr, "cooperative launch failed: %s\n", hipGetErrorString(e));
#else
    for (int ph = 0; ph < N_PHASES; ++ph) { p.ph_lo = ph; p.ph_hi = ph + 1; hipLaunchKernelGGL(fwd_kernel, dim3(grid), dim3(512), LDS_BYTES, stream, p);
#ifdef PROBE_REPEAT
        if (ph == PROBE_REPEAT) for (int rr = 0; rr < PROBE_TIMES; ++rr) hipLaunchKernelGGL(fwd_kernel, dim3(grid), dim3(512), LDS_BYTES, stream, p);
#endif
    }
#endif
}
```

```cpp
#include <hip/hip_runtime.h>
#define MK_LAUNCHES 1
#include <hip/hip_cooperative_groups.h>
#include <cstdio>
#include <cstdint>
namespace cg = cooperative_groups;

#define DI __device__ __forceinline__
#define LAS __attribute__((address_space(3)))
typedef unsigned short bf16_t;
typedef short bf16x8 __attribute__((ext_vector_type(8)));
typedef short s16x4 __attribute__((ext_vector_type(4)));
typedef float f32x2 __attribute__((ext_vector_type(2)));
typedef float f32x4 __attribute__((ext_vector_type(4)));
typedef float f32x16 __attribute__((ext_vector_type(16)));
typedef unsigned u32x2 __attribute__((ext_vector_type(2)));
typedef unsigned u32x4 __attribute__((ext_vector_type(4)));
typedef __bf16 bf16x2_t __attribute__((ext_vector_type(2)));

DI unsigned pk2(float lo, float hi) { f32x2 v = {lo, hi}; bf16x2_t b = __builtin_convertvector(v, bf16x2_t); return __builtin_bit_cast(unsigned, b); }
DI float bflo(unsigned u) { return __uint_as_float(u << 16); }
DI float bfhi(unsigned u) { return __uint_as_float(u & 0xffff0000u); }
DI float bf2f(bf16_t b) { return __uint_as_float((unsigned)b << 16); }
DI bf16_t f2bf(float f) { return (bf16_t)(pk2(f, 0.f) & 0xffffu); }
DI float fast_exp2(float x) { return __builtin_amdgcn_exp2f(x); }
DI float sigmoidf_(float x) { return __builtin_amdgcn_rcpf(1.0f + __expf(-x)); }
DI float siluf_(float x) { return x * __builtin_amdgcn_rcpf(1.0f + __expf(-x)); }
DI const float* opaque_ptr(const float* p) { asm volatile("" : "+s"(p)); return p; }
DI float shx(float v, int m, int lane) { return __int_as_float(__builtin_amdgcn_ds_bpermute((lane ^ m) << 2, __float_as_int(v))); }
DI float xhalf_max(float v) { const auto s = __builtin_amdgcn_permlane32_swap(__float_as_uint(v), __float_as_uint(v), false, false); return fmaxf(__uint_as_float(s[0]), __uint_as_float(s[1])); }
DI float xhalf_sum(float v) { const auto s = __builtin_amdgcn_permlane32_swap(__float_as_uint(v), __float_as_uint(v), false, false); return __uint_as_float(s[0]) + __uint_as_float(s[1]); }
DI float wave_sum(float v, int lane) {
#pragma unroll
    for (int o = 1; o < 64; o <<= 1) v += shx(v, o, lane);
    return v;
}
DI void sincos_d(double x, double& s, double& c) {
    const double inv = 0.63661977236758134308;
    const double q = __builtin_rint(x * inv);
    const double p1 = 1.57079632673412561417e+00, p2 = 6.07710050650619224932e-11, p3 = 2.02226624879595063154e-21;
    double r = x - q * p1; r -= q * p2; r -= q * p3;
    const double r2 = r * r;
    double sp = -1.0 / 121645100408832000.0;
    sp = sp * r2 + 1.0 / 355687428096000.0;
    sp = sp * r2 - 1.0 / 1307674368000.0;
    sp = sp * r2 + 1.0 / 6227020800.0;
    sp = sp * r2 - 1.0 / 39916800.0;
    sp = sp * r2 + 1.0 / 362880.0;
    sp = sp * r2 - 1.0 / 5040.0;
    sp = sp * r2 + 1.0 / 120.0;
    sp = sp * r2 - 1.0 / 6.0;
    const double sr = r + r * r2 * sp;
    double cp = 1.0 / 6402373705728000.0;
    cp = cp * r2 - 1.0 / 20922789888000.0;
    cp = cp * r2 + 1.0 / 87178291200.0;
    cp = cp * r2 - 1.0 / 479001600.0;
    cp = cp * r2 + 1.0 / 3628800.0;
    cp = cp * r2 - 1.0 / 40320.0;
    cp = cp * r2 + 1.0 / 720.0;
    cp = cp * r2 - 1.0 / 24.0;
    cp = cp * r2 + 0.5;
    const double cr = 1.0 - r2 * cp;
    const int qi = (int)q & 3;
    s = (qi == 0) ? sr : (qi == 1) ? cr : (qi == 2) ? -sr : -cr;
    c = (qi == 0) ? cr : (qi == 1) ? -sr : (qi == 2) ? -cr : sr;
}

namespace pg8 {
constexpr int BM = 256, BK = 64, HALF = 128, HTB = HALF * BK * 2, STAGE_BYTES = 8 * HTB;
DI int lds_byte(int r, int c) { const int st = (r >> 4) * 2 + (c >> 5), rr = r & 15, cc = c & 31, ob = rr * 64 + cc * 2; return st * 1024 + (ob ^ (((ob >> 9) & 1) << 5)); }
DI void stage_rc(int b, int& R, int& C) { const int st = b / 1024, sb = b % 1024, swz = sb ^ (((sb >> 9) & 1) << 5); R = (st >> 1) * 16 + swz / 64; C = (st & 1) * 32 + (swz % 64) / 2; }
DI int perm32(int rho) { const int n = rho >> 4, i = rho & 15; return 8 * (i >> 2) + 4 * n + (i & 3); }

struct Unit { const char* a; const char* b; void* o0; const void* o1; const void* o2; int ld; int rows; int flag; const int* gidx; };

template <class Epi, class Sched, bool ALIGN_EPI, bool SP2, bool GATHER = false>
DI void gemm_phase(LAS unsigned char* lds, const int K, const Sched& S, const Epi& E, const int tid, const int lda = 0, const int ldb = 0) {
    const int LA = lda ? lda : K, LB = ldb ? ldb : K;
    const int  wid = __builtin_amdgcn_readfirstlane(tid >> 6), lane = tid & 63, wr = wid >> 2, wc = wid & 3, fr = lane & 15, fq = lane >> 4;
    const int nt = K / BK;
    unsigned voffA[2], voffB[2];
#pragma unroll
    for (int i = 0; i < 2; ++i) { int R, C; stage_rc(tid * 16 + i * 8192, R, C); const int Rb = Epi::PERM ? ((R & ~31) + perm32(R & 31)) : R;
        voffA[i] = (unsigned)(R * LA + C) * 2u; voffB[i] = (unsigned)(Rb * LB + C) * 2u; }
    const size_t kstep = (size_t)(BK * 2);
    const size_t hstepA = (size_t)HALF * LA * 2, hstepB = (size_t)HALF * LB * 2;
    const unsigned ldsw = (unsigned)wid * 1024u;
    const int aoff = lds_byte(wr * 64 + fr, fq * 8), boff = lds_byte(wc * 32 + fr, fq * 8);
#define PG8_SA(b, h) (((b) * 2 + (h)) * HTB)
#define PG8_SB(b, h) ((4 + (b) * 2 + (h)) * HTB)
#define PG8_STAGE(bufoff, gbase, voff) do { _Pragma("unroll") for (int _i = 0; _i < 2; ++_i) \
        __builtin_amdgcn_global_load_lds((const unsigned*)((const char*)(gbase) + (voff)[_i]), (LAS unsigned*)(lds + (bufoff) + ldsw + _i * 8192), 16, 0, 0); } while (0)
#define PG8_STAGE_A(bufoff, gbase, half, nextu) do { if constexpr (GATHER) { _Pragma("unroll") for (int _i = 0; _i < 2; ++_i) { const unsigned _o = (nextu) ? gnx[half][_i] : gof[half][_i]; \
        __builtin_amdgcn_global_load_lds((const unsigned*)((const char*)(gbase) + _o), (LAS unsigned*)(lds + (bufoff) + ldsw + _i * 8192), 16, 0, 0); } } \
        else { PG8_STAGE(bufoff, (gbase) + ((half) ? hstepA : 0), voffA); } } while (0)
#define PG8_LDA(dst, b, h) do { _Pragma("unroll") for (int m = 0; m < 4; ++m) _Pragma("unroll") for (int k = 0; k < 2; ++k) dst[m][k] = *(const LAS bf16x8*)(lds + PG8_SA(b, h) + aoff + m * 2048 + k * 1024); } while (0)
#define PG8_LDB(dst, b, h) do { _Pragma("unroll") for (int n = 0; n < 2; ++n) _Pragma("unroll") for (int k = 0; k < 2; ++k) dst[n][k] = *(const LAS bf16x8*)(lds + PG8_SB(b, h) + boff + n * 2048 + k * 1024); } while (0)
#define PG8_MMA(ai, bj, At, Bt) do { __builtin_amdgcn_s_setprio(1); _Pragma("unroll") for (int m = 0; m < 4; ++m) _Pragma("unroll") for (int n = 0; n < 2; ++n) _Pragma("unroll") for (int k = 0; k < 2; ++k) \
        acc[ai][bj][m][n] = __builtin_amdgcn_mfma_f32_16x16x32_bf16(Bt[n][k], At[m][k], acc[ai][bj][m][n], 0, 0, 0); __builtin_amdgcn_s_setprio(0); } while (0)
#define PG8_WAIT_V(n) asm volatile("s_waitcnt vmcnt(" #n ")" ::: "memory")
#define PG8_WAIT_L(n) asm volatile("s_waitcnt lgkmcnt(" #n ")" ::: "memory")
#define PG8_BAR __builtin_amdgcn_s_barrier()
#define PG8_SCHED __builtin_amdgcn_sched_barrier(0)
    Unit cur, nxt; int ui = 0;
    if (!S.next(0, cur)) return;
    unsigned gof[2][2], gnx[2][2];
    if constexpr (GATHER) {
#pragma unroll
        for (int hh = 0; hh < 2; ++hh)
#pragma unroll
            for (int i = 0; i < 2; ++i) { int gR, gC; stage_rc(tid * 16 + i * 8192, gR, gC); const int r = hh * HALF + gR; const int row = (r < cur.rows) ? (cur.gidx[r] >> 1) : 0; gof[hh][i] = (unsigned)(row * LA + gC) * 2u; gnx[hh][i] = gof[hh][i]; }
    }
    f32x4 acc[2][2][4][2];
#pragma unroll
    for (int a = 0; a < 2; ++a)
#pragma unroll
        for (int b = 0; b < 2; ++b)
#pragma unroll
            for (int m = 0; m < 4; ++m)
#pragma unroll
                for (int n = 0; n < 2; ++n) acc[a][b][m][n] = (f32x4){0.f, 0.f, 0.f, 0.f};
    bf16x8 At[4][2], B0[2][2], B1[2][2];
    const char* cA = cur.a; const char* cB = cur.b;
    if constexpr (SP2) {
        PG8_STAGE(PG8_SB(0, 0), cB, voffB); PG8_STAGE(PG8_SB(0, 1), cB + hstepB, voffB); PG8_STAGE_A(PG8_SA(0, 0), cA, 0, false); PG8_STAGE_A(PG8_SA(0, 1), cA, 1, false);
        if (wr == 1) PG8_BAR;
        PG8_WAIT_V(2); PG8_BAR;
        PG8_STAGE(PG8_SB(1, 0), cB + kstep, voffB); PG8_STAGE_A(PG8_SA(1, 0), cA + kstep, 0, false); PG8_STAGE(PG8_SB(1, 1), cB + hstepB + kstep, voffB);
        PG8_WAIT_V(6); PG8_BAR;
    } else {
        PG8_STAGE(PG8_SB(0, 0), cB, voffB); PG8_STAGE_A(PG8_SA(0, 0), cA, 0, false); PG8_STAGE(PG8_SB(0, 1), cB + hstepB, voffB); PG8_STAGE_A(PG8_SA(0, 1), cA, 1, false);
        if (wr == 1) PG8_BAR;
        PG8_WAIT_V(4); PG8_BAR;
        PG8_STAGE(PG8_SB(1, 0), cB + kstep, voffB); PG8_STAGE_A(PG8_SA(1, 0), cA + kstep, 0, false); PG8_STAGE(PG8_SB(1, 1), cB + hstepB + kstep, voffB);
        PG8_WAIT_V(6); PG8_BAR;
    }
    for (;;) {
        const bool has_next = S.next(ui + 1, nxt);
        if constexpr (GATHER) { if (has_next) {
#pragma unroll
            for (int hh = 0; hh < 2; ++hh)
#pragma unroll
                for (int i = 0; i < 2; ++i) { unsigned am2 = ~0u; asm volatile("" : "+s"(am2)); const int t2 = wid * 64 + (int)__builtin_amdgcn_mbcnt_hi(am2, __builtin_amdgcn_mbcnt_lo(am2, 0u)); int gR, gC; stage_rc(t2 * 16 + i * 8192, gR, gC); const int r = hh * HALF + gR; const int row = (r < nxt.rows) ? (nxt.gidx[r] >> 1) : 0; gnx[hh][i] = (unsigned)(row * LA + gC) * 2u; } } }
        const char* nA = has_next ? nxt.a : cA; const char* nB = has_next ? nxt.b : cB;
        for (int t = 0; t < nt; t += 2) {
            const bool last = (t == nt - 2);
            const char* a1 = cA + (size_t)(t + 1) * kstep;
            const char* a2 = last ? nA : cA + (size_t)(t + 2) * kstep; const char* b2 = last ? nB : cB + (size_t)(t + 2) * kstep;
            const char* a3 = a2 + kstep; const char* b3 = b2 + kstep;
            if constexpr (SP2) {
            PG8_LDB(B0, 0, 0); PG8_LDB(B1, 0, 1); PG8_SCHED; PG8_LDA(At, 0, 0); PG8_STAGE_A(PG8_SA(1, 1), a1, 1, false);
            PG8_WAIT_V(8); PG8_WAIT_L(0); PG8_BAR; PG8_MMA(0, 0, At, B0); PG8_MMA(0, 1, At, B1); PG8_BAR; PG8_SCHED;
            PG8_LDA(At, 0, 1); PG8_STAGE(PG8_SB(0, 0), b2, voffB); PG8_STAGE(PG8_SB(0, 1), b2 + hstepB, voffB); PG8_STAGE_A(PG8_SA(0, 0), a2, 0, last);
            PG8_WAIT_V(8); PG8_WAIT_L(0); PG8_BAR; PG8_MMA(1, 0, At, B0); PG8_MMA(1, 1, At, B1); PG8_BAR; PG8_SCHED;
            PG8_LDB(B0, 1, 0); PG8_LDB(B1, 1, 1); PG8_SCHED; PG8_LDA(At, 1, 0); PG8_STAGE_A(PG8_SA(0, 1), a2, 1, last);
            PG8_WAIT_V(8); PG8_WAIT_L(0); PG8_BAR; PG8_MMA(0, 0, At, B0); PG8_MMA(0, 1, At, B1); PG8_BAR; PG8_SCHED;
            PG8_LDA(At, 1, 1); PG8_STAGE(PG8_SB(1, 0), b3, voffB); PG8_STAGE(PG8_SB(1, 1), b3 + hstepB, voffB); PG8_STAGE_A(PG8_SA(1, 0), a3, 0, last);
            PG8_WAIT_V(8); PG8_WAIT_L(0); PG8_BAR; PG8_MMA(1, 0, At, B0); PG8_MMA(1, 1, At, B1); PG8_BAR; PG8_SCHED;
            } else {
            PG8_LDB(B0, 0, 0); PG8_SCHED; PG8_LDA(At, 0, 0); PG8_STAGE_A(PG8_SA(1, 1), a1, 1, false);
            PG8_WAIT_L(8); PG8_BAR; PG8_WAIT_L(0); PG8_MMA(0, 0, At, B0); PG8_BAR; PG8_SCHED;
            PG8_LDB(B1, 0, 1); PG8_STAGE(PG8_SB(0, 0), b2, voffB);
            PG8_BAR; PG8_WAIT_L(0); PG8_MMA(0, 1, At, B1); PG8_BAR;
            PG8_LDA(At, 0, 1); PG8_STAGE_A(PG8_SA(0, 0), a2, 0, last);
            PG8_BAR; PG8_WAIT_L(0); PG8_MMA(1, 0, At, B0); PG8_BAR; PG8_SCHED;
            PG8_STAGE(PG8_SB(0, 1), b2 + hstepB, voffB);
            PG8_WAIT_V(6); PG8_BAR; PG8_MMA(1, 1, At, B1); PG8_BAR;
            PG8_LDB(B0, 1, 0); PG8_SCHED; PG8_LDA(At, 1, 0); PG8_STAGE_A(PG8_SA(0, 1), a2, 1, last);
            PG8_WAIT_L(8); PG8_BAR; PG8_WAIT_L(0); PG8_MMA(0, 0, At, B0); PG8_BAR; PG8_SCHED;
            PG8_LDB(B1, 1, 1); PG8_STAGE(PG8_SB(1, 0), b3, voffB);
            PG8_BAR; PG8_WAIT_L(0); PG8_MMA(0, 1, At, B1); PG8_BAR;
            PG8_LDA(At, 1, 1); PG8_STAGE_A(PG8_SA(1, 0), a3, 0, last);
            PG8_BAR; PG8_WAIT_L(0); PG8_MMA(1, 0, At, B0); PG8_BAR; PG8_SCHED;
            PG8_STAGE(PG8_SB(1, 1), b3 + hstepB, voffB);
            PG8_WAIT_V(6); PG8_BAR; PG8_MMA(1, 1, At, B1); PG8_BAR;
            }
        }
        if constexpr (ALIGN_EPI) { if (wr == 0) PG8_BAR; }
        unsigned ame = ~0u; asm volatile("" : "+s"(ame)); const int lne = (int)__builtin_amdgcn_mbcnt_hi(ame, __builtin_amdgcn_mbcnt_lo(ame, 0u));
        const bool keep = E(acc, cur, wr, wc, lne & 15, lne >> 4);
        if constexpr (Sched::PUBLISH) S.done(cur);
        if (!has_next) break;
        if (!keep) {
#pragma unroll
        for (int a = 0; a < 2; ++a)
#pragma unroll
            for (int b = 0; b < 2; ++b)
#pragma unroll
                for (int m = 0; m < 4; ++m)
#pragma unroll
                    for (int n = 0; n < 2; ++n) acc[a][b][m][n] = (f32x4){0.f, 0.f, 0.f, 0.f};
        }
        if constexpr (GATHER) {
#pragma unroll
            for (int hh = 0; hh < 2; ++hh)
#pragma unroll
                for (int i = 0; i < 2; ++i) gof[hh][i] = gnx[hh][i]; }
        cur = nxt; cA = nA; cB = nB; ++ui;
        if constexpr (ALIGN_EPI) { if (wr == 1) PG8_BAR; }
    }
    PG8_WAIT_V(0);
    if constexpr (!ALIGN_EPI) { if (wr == 0) PG8_BAR; }
    PG8_BAR;
#undef PG8_SA
#undef PG8_SB
#undef PG8_STAGE
#undef PG8_STAGE_A
#undef PG8_LDA
#undef PG8_LDB
#undef PG8_MMA
#undef PG8_WAIT_V
#undef PG8_WAIT_L
#undef PG8_BAR
#undef PG8_SCHED
}
}
constexpr int D = 1024, NB = 8, NSEQ = 2048, LCTX = 256, DEPTH = 2;
constexpr int R_CTX = NB * LCTX, R_LAT = NB * NSEQ, R_ALL = R_CTX + R_LAT;
constexpr int IN_COLS = 6400, PCOLS = 5888;
constexpr int HM_COLS = 2816, GATE_LD = 3072;
constexpr int PC_QA = 0, PC_KA = 512, PC_VA = 640, PC_QR = 768, PC_KR = 1280, PC_VR = 1792, PC_GR = 2304, PC_GATE = 2816;
constexpr int OC_FU = 2816, OC_GATE = 3328;
constexpr int NEXP = 32, EH = 512;
constexpr int P_ROWS = 2 * R_ALL + 256;
constexpr size_t MiB = 1u << 20, KiB = 1u << 10;
constexpr size_t WS_CTL = 0, CTL_BYTES = 256 * KiB;
constexpr size_t WS_TAB = 256 * KiB, WS_MODS = 832 * KiB, WS_ROUTE = 1264 * KiB, WS_FL = 1904 * KiB, WS_UTC = 2304 * KiB, WS_FN = WS_UTC + 4 * MiB;
constexpr size_t WS_WSMALL = WS_FN + 16 * MiB, WSMALL_LAYER = (size_t)(18.5 * MiB);
constexpr size_t WO_WIN = 0, WO_WF = (size_t)(11.5 * MiB), WO_WBA = (size_t)(13.5 * MiB), WO_WBF = (size_t)(14.5 * MiB), WO_WBR = (size_t)(15.5 * MiB), WO_WOUT = (size_t)(16.5 * MiB);
constexpr size_t WS_WGU = WS_WSMALL + 37 * MiB, WS_WD = WS_WGU + 64 * MiB;
constexpr size_t WS_H = WS_WD + 32 * MiB;
constexpr size_t WS_SST = WS_H + 36 * MiB;
constexpr size_t WS_OA = WS_SST + 18 * MiB, WS_OF = WS_OA + 18 * MiB, WS_UT = WS_OF + 18 * MiB, WS_RET = WS_UT + 32 * MiB;
constexpr size_t WS_XL = WS_RET + 18 * MiB;
constexpr size_t WS_W0GU = WS_XL + 36 * MiB, WS_W0D = WS_W0GU + 64 * MiB;
constexpr size_t WS_PROJ = WS_W0GU + 24 * MiB;
constexpr size_t WS_XG = WS_PROJ, WS_ACT = WS_XG + (size_t)P_ROWS * 1024 * 2, WS_YS = WS_ACT + (size_t)P_ROWS * 512 * 2;
constexpr size_t WS_END = WS_PROJ + (size_t)R_ALL * PCOLS * 2;
static_assert(WS_W0D + 32 * MiB <= WS_XG + (size_t)P_ROWS * 1024 * 2 && WS_W0D + 32 * MiB <= WS_PROJ + (size_t)HM_COLS * R_ALL * 2, "layer-0 expert weights end inside the dead head-major part of proj, below the act buffer");
static_assert(WS_YS + (size_t)P_ROWS * 1024 * 2 <= WS_END, "MoE buffers fit in the proj region");
constexpr size_t WS_WRT = WS_END, WS_END2 = WS_WRT + (size_t)2 * 2 * 64 * 1024 * 2;
static_assert(WS_END2 <= 602284512ull, "workspace map must fit sum(inputs) bytes");
static_assert(WS_TAB + (16384 + 2 * 65536) * 4 <= WS_MODS && WS_MODS + 2 * 9 * 6144 * 4 <= WS_ROUTE && WS_ROUTE + 640 * KiB <= WS_FL && WS_FL + 256 * KiB <= WS_UTC, "small regions");
constexpr int CW_BLK = 16384;
constexpr int CW_BAR = 4096;
constexpr int CW_GQ = 61696, CW_GT = 62464;
constexpr int CW_MODS = 61440;
constexpr int CW_PANEL = 49152;
constexpr int CW_FLAG = 32768;
constexpr int TB_ROWC = 0, TB_ROWS = 512, TB_COLC = 1024, TB_COLS = 2048, TB_LG = 3072  , TB_RETC = 16384, TB_RETS = 16384 + 65536;
constexpr size_t RT_TOKE = 0, RT_TOKW = 160 * 1024, RT_SDST = 320 * 1024, RT_SW = 480 * 1024;
constexpr int LDS_BYTES = 155648;
constexpr int LDS_TBL = 131072;

struct EpiStore {
    static constexpr bool PERM = true;
    DI bool operator()(f32x4 (&acc)[2][2][4][2], const pg8::Unit& u, int wr, int wc, int fr_, int fq_) const {
        int fr = fr_, fq = fq_; asm volatile("" : "+v"(fr), "+v"(fq));
        bf16_t* O = (bf16_t*)u.o0; const int ld = u.ld; const bool hm = u.flag == 2;
#pragma unroll
        for (int ai = 0; ai < 2; ++ai)
#pragma unroll
            for (int m = 0; m < 4; ++m) { const int r = ai * 128 + wr * 64 + m * 16 + fr;
                if (hm) {
#pragma unroll
                    for (int bj = 0; bj < 2; ++bj) { const int cc = bj * 128 + wc * 32 + 8 * fq; const f32x4 v0 = acc[ai][bj][m][0], v1 = acc[ai][bj][m][1];
                        u32x4 w; w.x = pk2(v0[0], v0[1]); w.y = pk2(v0[2], v0[3]); w.z = pk2(v1[0], v1[1]); w.w = pk2(v1[2], v1[3]);
                        *(u32x4*)(O + ((size_t)(cc >> 6) * R_ALL + r) * 64 + (cc & 63)) = w; }
                } else
                if (r < u.rows) { bf16_t* rowp = O + (size_t)r * ld + wc * 32 + 8 * fq;
#pragma unroll
                    for (int bj = 0; bj < 2; ++bj) { const f32x4 v0 = acc[ai][bj][m][0], v1 = acc[ai][bj][m][1];
                        u32x4 w; w.x = pk2(v0[0], v0[1]); w.y = pk2(v0[2], v0[3]); w.z = pk2(v1[0], v1[1]); w.w = pk2(v1[2], v1[3]);
                        *(u32x4*)(rowp + bj * 128) = w; } } }
        return false;
    }
};
struct EpiNone { static constexpr bool PERM = true; DI bool operator()(f32x4 (&acc)[2][2][4][2], const pg8::Unit& u, int wr, int wc, int fr, int fq) const {
#pragma unroll
    for (int a = 0; a < 2; ++a)
#pragma unroll
        for (int b = 0; b < 2; ++b)
#pragma unroll
            for (int m = 0; m < 4; ++m)
#pragma unroll
                for (int n = 0; n < 2; ++n) asm volatile("" :: "v"(acc[a][b][m][n])); return false; } };
struct EpiMerge {
    static constexpr bool PERM = true;
    DI bool operator()(f32x4 (&acc)[2][2][4][2], const pg8::Unit& u, int wr, int wc, int fr_, int fq_) const {
        int fr = fr_, fq = fq_; asm volatile("" : "+v"(fr), "+v"(fq));
        bf16_t* M = (bf16_t*)u.o0; const bf16_t* G = (const bf16_t*)u.o1; const int br = u.flag;
        if (br < 2) {
#pragma unroll
            for (int ai = 0; ai < 2; ++ai) {
                u32x4 gc[4][2], gn[4][2];
#pragma unroll
                for (int m = 0; m < 4; ++m) { const int r = ai * 128 + wr * 64 + m * 16 + fr;
#pragma unroll
                    for (int bj = 0; bj < 2; ++bj) { const bf16_t* gp = G + (size_t)r * GATE_LD + wc * 32 + 8 * fq + bj * 128; gc[m][bj] = *(const u32x4*)gp; gn[m][bj] = *(const u32x4*)(gp + 1024); } }
#pragma unroll
                for (int m = 0; m < 4; ++m)
#pragma unroll
                    for (int bj = 0; bj < 2; ++bj) { const u32x4 c = gc[m][bj], n = gn[m][bj];
#define RATIO(xc, xn) ((1.0f + __expf(-fminf(fmaxf((xn), -30.f), 30.f))) * __builtin_amdgcn_rcpf(1.0f + __expf(-fminf(fmaxf((xc), -30.f), 30.f))))
                        f32x4& v0 = acc[ai][bj][m][0]; f32x4& v1 = acc[ai][bj][m][1];
                        v0[0] *= RATIO(bflo(c.x), bflo(n.x)); v0[1] *= RATIO(bfhi(c.x), bfhi(n.x)); v0[2] *= RATIO(bflo(c.y), bflo(n.y)); v0[3] *= RATIO(bfhi(c.y), bfhi(n.y));
                        v1[0] *= RATIO(bflo(c.z), bflo(n.z)); v1[1] *= RATIO(bfhi(c.z), bfhi(n.z)); v1[2] *= RATIO(bflo(c.w), bflo(n.w)); v1[3] *= RATIO(bfhi(c.w), bfhi(n.w));
#undef RATIO
                    }
            }
            return true;
        }
        const unsigned long long ma = (unsigned long long)M; const unsigned mlo = __builtin_amdgcn_readfirstlane((unsigned)ma), mhi = __builtin_amdgcn_readfirstlane((unsigned)(ma >> 32));
        const __amdgpu_buffer_rsrc_t mrs = __builtin_amdgcn_make_buffer_rsrc((void*)(((unsigned long long)mhi << 32) | mlo), 0, 0x7FFFFFF0, 0x00020000);
#pragma unroll
        for (int ai = 0; ai < 2; ++ai) {
            u32x4 gq[4][2];
#pragma unroll
            for (int m = 0; m < 4; ++m) { const int r = ai * 128 + wr * 64 + m * 16 + fr;
#pragma unroll
                for (int bj = 0; bj < 2; ++bj) gq[m][bj] = *(const u32x4*)(G + (size_t)r * GATE_LD + wc * 32 + 8 * fq + bj * 128); }
#pragma unroll
            for (int m = 0; m < 4; ++m) { const int r = ai * 128 + wr * 64 + m * 16 + fr; const unsigned moff = ((unsigned)r * 1024u + (unsigned)(wc * 32 + 8 * fq)) * 2u;
#pragma unroll
                for (int bj = 0; bj < 2; ++bj) { const f32x4 v0 = acc[ai][bj][m][0], v1 = acc[ai][bj][m][1]; const u32x4 g = gq[m][bj];
#define SG(x) sigmoidf_(fminf(fmaxf((x), -30.f), 30.f))
                    u32x4 w; w.x = pk2(SG(bflo(g.x)) * v0[0], SG(bfhi(g.x)) * v0[1]); w.y = pk2(SG(bflo(g.y)) * v0[2], SG(bfhi(g.y)) * v0[3]);
                    w.z = pk2(SG(bflo(g.z)) * v1[0], SG(bfhi(g.z)) * v1[1]); w.w = pk2(SG(bflo(g.w)) * v1[2], SG(bfhi(g.w)) * v1[3]);
#undef SG
                    __builtin_amdgcn_raw_buffer_store_b128(w, mrs, moff + bj * 256u, 0, 16); } }
        }
        return false;
    }
};
struct EpiOut {
    static constexpr bool PERM = true;
    DI bool operator()(f32x4 (&acc)[2][2][4][2], const pg8::Unit& u, int wr, int wc, int fr_, int fq_) const {
        int fr = fr_, fq = fq_; asm volatile("" : "+v"(fr), "+v"(fq));
        bf16_t* Dst = (bf16_t*)u.o0; const float* gvec = (const float*)u.o2; const bool f32src = u.flag != 0;
        f32x4 gv[2][2];
#pragma unroll
        for (int bj = 0; bj < 2; ++bj)
#pragma unroll
            for (int n = 0; n < 2; ++n) gv[bj][n] = *(const f32x4*)(gvec + bj * 128 + wc * 32 + 8 * fq + 4 * n);
#pragma unroll
        for (int ai = 0; ai < 2; ++ai) {
            f32x4 sv[4][2][2];
#pragma unroll
            for (int m = 0; m < 4; ++m) { const int r = ai * 128 + wr * 64 + m * 16 + fr;
#pragma unroll
                for (int bj = 0; bj < 2; ++bj) { const size_t off = (size_t)r * 1024 + bj * 128 + wc * 32 + 8 * fq;
                    if (f32src) { const float* sp = (const float*)u.o1 + off; sv[m][bj][0] = *(const f32x4*)sp; sv[m][bj][1] = *(const f32x4*)(sp + 4); }
                    else { const u32x4 q = *(const u32x4*)((const bf16_t*)u.o1 + off); sv[m][bj][0] = (f32x4){bflo(q.x), bfhi(q.x), bflo(q.y), bfhi(q.y)}; sv[m][bj][1] = (f32x4){bflo(q.z), bfhi(q.z), bflo(q.w), bfhi(q.w)}; } } }
#pragma unroll
            for (int m = 0; m < 4; ++m) { const int r = ai * 128 + wr * 64 + m * 16 + fr;
#pragma unroll
                for (int bj = 0; bj < 2; ++bj) { const f32x4 v0 = sv[m][bj][0] + gv[bj][0] * acc[ai][bj][m][0], v1 = sv[m][bj][1] + gv[bj][1] * acc[ai][bj][m][1];
                    u32x4 w; w.x = pk2(v0[0], v0[1]); w.y = pk2(v0[2], v0[3]); w.z = pk2(v1[0], v1[1]); w.w = pk2(v1[2], v1[3]);
                    *(u32x4*)(Dst + (size_t)r * 1024 + bj * 128 + wc * 32 + 8 * fq) = w; } }
        }
        return false;
    }
};
template <bool WT>
struct EpiGU_ {
    static constexpr bool PERM = true;
    DI bool operator()(f32x4 (&acc)[2][2][4][2], const pg8::Unit& u, int wr, int wc, int fr_, int fq_) const {
        int fr = fr_, fq = fq_; asm volatile("" : "+v"(fr), "+v"(fq));
        bf16_t* O = (bf16_t*)u.o0;
        const __amdgpu_buffer_rsrc_t rs = __builtin_amdgcn_make_buffer_rsrc(O, 0, 0x7FFFFFF0, 0x00020000);
#pragma unroll
        for (int ai = 0; ai < 2; ++ai)
#pragma unroll
            for (int mp = 0; mp < 2; ++mp) { const int mm = 2 * mp + (fq & 1), r = ai * 128 + wr * 64 + mm * 16 + fr; const unsigned eoff = (unsigned)r * 512u + (unsigned)(wc * 16 + 4 * (fq & ~1));
#pragma unroll
                for (int bj = 0; bj < 2; ++bj) { u32x2 w[2];
#pragma unroll
                    for (int q = 0; q < 2; ++q) { const f32x4 g = acc[ai][bj][2 * mp + q][0], v = acc[ai][bj][2 * mp + q][1];
                        w[q].x = pk2(siluf_(g[0]) * v[0], siluf_(g[1]) * v[1]); w[q].y = pk2(siluf_(g[2]) * v[2], siluf_(g[3]) * v[3]); }
                    const auto s0 = __builtin_amdgcn_permlane16_swap(w[0].x, w[1].x, false, false), s1 = __builtin_amdgcn_permlane16_swap(w[0].y, w[1].y, false, false);
                    u32x4 o; o.x = s0[0]; o.y = s1[0]; o.z = s0[1]; o.w = s1[1];
                    if (r < u.rows) {
                        if constexpr (WT) __builtin_amdgcn_raw_buffer_store_b128(o, rs, (eoff + bj * 64) * 2u, 0, 16);
                        else *(u32x4*)(O + eoff + bj * 64) = o; } } }
        return false;
    }
};
using EpiGU = EpiGU_<false>;
struct EpiDown {
    static constexpr bool PERM = true;
    DI bool operator()(f32x4 (&acc)[2][2][4][2], const pg8::Unit& u, int wr, int wc, int fr_, int fq_) const {
        int fr = fr_, fq = fq_; asm volatile("" : "+v"(fr), "+v"(fq));
        bf16_t* Y = (bf16_t*)u.o0; const float* sw = (const float*)u.o2;
        float ww[2][4];
#pragma unroll
        for (int ai = 0; ai < 2; ++ai)
#pragma unroll
            for (int m = 0; m < 4; ++m) { const int r = ai * 128 + wr * 64 + m * 16 + fr; ww[ai][m] = (r < u.rows) ? sw[r] : 0.f; }
#pragma unroll
        for (int ai = 0; ai < 2; ++ai)
#pragma unroll
            for (int m = 0; m < 4; ++m) { const int r = ai * 128 + wr * 64 + m * 16 + fr;
                if (r < u.rows) { const float wt = ww[ai][m]; bf16_t* rowp = Y + (size_t)r * 1024 + wc * 32 + 8 * fq;
#pragma unroll
                    for (int bj = 0; bj < 2; ++bj) { const f32x4 v0 = acc[ai][bj][m][0] * wt, v1 = acc[ai][bj][m][1] * wt;
                        u32x4 w; w.x = pk2(v0[0], v0[1]); w.y = pk2(v0[2], v0[3]); w.z = pk2(v1[0], v1[1]); w.w = pk2(v1[2], v1[3]);
                        *(u32x4*)(rowp + bj * 128) = w; } } }
        return false;
    }
};

DI void tile_of(int L, int nM, int nN, int& pm, int& pn) {
    const int nwg = nM * nN;
    int wgid = L; { const int q = nwg / 8, r = nwg % 8, xcd = wgid % 8, off = wgid / 8; wgid = (xcd < r ? xcd * (q + 1) : r * (q + 1) + (xcd - r) * q) + off; }
    const int nig = 4 * nN, gid = wgid / nig, fm = gid * 4, gsz = (nM - fm) < 4 ? (nM - fm) : 4;
    pm = fm + ((wgid % nig) % gsz); pn = (wgid % nig) / gsz;
}
DI int xcd_remap(int L, int nwg) { const int q = nwg / 8, r = nwg % 8, xcd = L % 8, off = L / 8; return (xcd < r ? xcd * (q + 1) : r * (q + 1) + (xcd - r) * q) + off; }
struct Params { const float* in[24]; float* out; unsigned char* ws; int ph_lo, ph_hi; };
typedef __attribute__((address_space(4))) const Params* KParams;
struct Ctx {
    KParams P; float* out; unsigned char* ws;
    DI const float* in(int i) const { return P->in[i]; }
    int G, c, tid;
    int wv;
    DI int fresh_tid() const { unsigned am = ~0u; asm volatile("" : "+s"(am)); return wv * 64 + (int)__builtin_amdgcn_mbcnt_hi(am, __builtin_amdgcn_mbcnt_lo(am, 0u)); }
    DI bool lead() const { unsigned am = ~0u; asm volatile("" : "+s"(am)); return wv == 0 && __builtin_amdgcn_mbcnt_lo(am, 0u) == 0u && __builtin_amdgcn_mbcnt_hi(am, 0u) == 0u; }
};
DI const bf16_t* PJ(const bf16_t* proj, int row, int col) { return proj + ((size_t)(col >> 6) * R_ALL + row) * 64 + (col & 63); }
DI bf16_t* wsmall(const Ctx& X, int l, size_t off) { return (bf16_t*)(X.ws + WS_WSMALL + (size_t)l * WSMALL_LAYER + off); }

struct SchedA {
    static constexpr bool PUBLISH = false;
    const Ctx* X; int l; int n_main, n_ctx, n_f, ftok0, nftok;
    DI void init(const Ctx* X_, int l_) { X = X_; l = l_;
        if (l == 0) { n_main = 72 * 23; n_ctx = 0; ftok0 = 0; nftok = 72; } else { n_main = 64 * 23; n_ctx = 8 * 5; ftok0 = 8; nftok = 64; }
        n_f = 4 * nftok; }
    DI bool next(int i, pg8::Unit& u) const {
        int L = i * X->G + X->c;
        const bf16_t* h = (const bf16_t*)(X->ws + WS_H); bf16_t* proj = (bf16_t*)(X->ws + WS_PROJ);
        u.rows = 256; u.flag = 0; u.o1 = nullptr; u.o2 = nullptr; u.gidx = nullptr;
        if (L < n_main) { int pm, pn; tile_of(L, l == 0 ? 72 : 64, 23, pm, pn); if (l != 0) pm += 8;
            u.a = (const char*)(h + (size_t)pm * 256 * 1024); u.b = (const char*)(wsmall(*X, l, WO_WIN) + (size_t)pn * 256 * 1024);
            if (pn < 11) { u.o0 = proj + ((size_t)(pn * 4) * R_ALL + pm * 256) * 64; u.ld = 64; u.flag = 2; } else { u.o0 = proj + (size_t)HM_COLS * R_ALL + (size_t)pm * 256 * GATE_LD + (pn - 11) * 256; u.ld = GATE_LD; }
            return true; }
        L -= n_main;
        if (L < n_ctx) { const int pm = L / 5, j = L % 5, pn = (j == 0) ? 2 : 4 + j;
            u.a = (const char*)(h + (size_t)pm * 256 * 1024); u.b = (const char*)(wsmall(*X, l, WO_WIN) + (size_t)pn * 256 * 1024);
            u.o0 = proj + ((size_t)(pn * 4) * R_ALL + pm * 256) * 64; u.ld = 64; u.flag = 2; return true; }
        L -= n_ctx;
        if (L < n_f) { const int w = xcd_remap(L, n_f); const int tt = ftok0 + w / 4, pm = w % 4, cs = pm >> 1, colbase = (pm & 1) * 256;
            u.a = (const char*)(wsmall(*X, l, WO_WF) + (size_t)pm * 256 * 1024); u.b = (const char*)(h + (size_t)tt * 256 * 1024);
            if (tt < 8) { u.o0 = (bf16_t*)(X->ws + WS_UTC) + ((size_t)(tt * 512 + colbase)) * 512 + cs * 256; u.ld = 512; }
            else { const int tl = tt - 8, bb = tl >> 3, n0 = (tl & 7) * 256; u.o0 = (bf16_t*)(X->ws + WS_UT) + ((size_t)(bb * 512 + colbase)) * 4096 + cs * 2048 + n0; u.ld = 4096; }
            return true; }
        return false;
    }
};
struct SchedF2 {
    static constexpr bool PUBLISH = false;
    const Ctx* X;
    DI bool next(int i, pg8::Unit& u) const {
        if (i != 0 || X->c >= 128) return false;
        const int L = X->c, b = L >> 4, pm = (L >> 1) & 7, pn = L & 1;
        u.a = (const char*)((const bf16_t*)(X->ws + WS_FN) + (size_t)pm * 256 * 2048); u.b = (const char*)((const bf16_t*)(X->ws + WS_UT) + ((size_t)(b * 512 + pn * 256)) * 4096);
        u.o0 = (bf16_t*)(X->ws + WS_OF) + ((size_t)(R_CTX + b * 2048 + pm * 256)) * 512 + pn * 256; u.ld = 512; u.rows = 256; u.flag = 0; u.o1 = nullptr; u.o2 = nullptr; u.gidx = nullptr; return true;
    }
};
struct SchedF2c {
    static constexpr bool PUBLISH = false;
    const Ctx* X;
    DI bool next(int i, pg8::Unit& u) const {
        if (i != 0 || X->c < 128 || X->c >= 144) return false;
        const int L = X->c - 128, b = L >> 1, pn = L & 1;
        u.a = (const char*)(X->ws + WS_FL); u.b = (const char*)((const bf16_t*)(X->ws + WS_UTC) + ((size_t)(b * 512 + pn * 256)) * 512);
        u.o0 = (bf16_t*)(X->ws + WS_OF) + ((size_t)(b * 256)) * 512 + pn * 256; u.ld = 512; u.rows = 256; u.flag = 0; u.o1 = nullptr; u.o2 = nullptr; u.gidx = nullptr; return true;
    }
};
DI bool merge_tile(int l, int G, int c, int j, int& pm, int& pn) {
    if (l != 0) { if (j != 0 || c >= 256) return false; tile_of(c, 64, 4, pm, pn); pm += 8; return true; }
    if (c >= 32) { if (j != 0 || c - 32 >= 224) return false; tile_of(c - 32, 56, 4, pm, pn); return true; }
    if (j > 1) return false; const int t2 = c * 2 + j; pm = 56 + (t2 >> 2); pn = t2 & 3; return true;
}
struct SchedM {
    static constexpr bool PUBLISH = false;
    const Ctx* X; int l;
    DI void init(const Ctx* X_, int l_) { X = X_; l = l_; }
    DI bool next(int i, pg8::Unit& u) const {
        const int br = i % 3; int pm, pn; if (!merge_tile(l, X->G, X->c, i / 3, pm, pn)) return false;
        const size_t src = (br == 0) ? WS_OA : (br == 1) ? WS_OF : WS_RET; const size_t wo = (br == 0) ? WO_WBA : (br == 1) ? WO_WBF : WO_WBR;
        u.a = (const char*)((const bf16_t*)(X->ws + src) + (size_t)pm * 256 * 512); u.b = (const char*)(wsmall(*X, l, wo) + (size_t)pn * 256 * 512);
        u.o0 = (bf16_t*)(X->ws + WS_H) + (size_t)pm * 256 * 1024 + pn * 256;
        u.o1 = (const bf16_t*)(X->ws + WS_PROJ) + (size_t)HM_COLS * R_ALL + (size_t)pm * 256 * GATE_LD + br * 1024 + pn * 256; u.o2 = nullptr; u.ld = 1024; u.rows = 256; u.flag = br; u.gidx = nullptr; return true;
    }
};
struct SchedO {
    static constexpr bool PUBLISH = false;
    const Ctx* X; int l;
    DI void init(const Ctx* X_, int l_) { X = X_; l = l_; }
    DI bool unit_tile(int i, int& pm, int& pn) const {
        if (l != 0) { if (i != 0) return false; tile_of(X->c, 64, 4, pm, pn); pm += 8; return true; }
        const int idx = X->c - 32; if (idx < 0) return false;
        if (i == 0) { tile_of(idx, 56, 4, pm, pn); return true; }
        if (i == 1 && idx < 64) { pm = 56 + (idx >> 2); pn = idx & 3; return true; }
        return false; }
    DI int panel_of(int i) const { int pm, pn; return unit_tile(i, pm, pn) ? pm : -1; }
    DI bool next(int i, pg8::Unit& u) const {
        int pm, pn; if (!unit_tile(i, pm, pn)) return false;
        u.a = (const char*)((const bf16_t*)(X->ws + WS_H) + (size_t)pm * 256 * 1024); u.b = (const char*)(wsmall(*X, l, WO_WOUT) + (size_t)pn * 256 * 1024);
        bf16_t* xl = (bf16_t*)(X->ws + WS_XL) + (size_t)pm * 256 * 1024 + pn * 256;
        const void* src = (l != 0) ? (const void*)xl : (const void*)(pm < 8 ? X->in(2) + (size_t)pm * 256 * 1024 + pn * 256 : X->in(0) + (size_t)(pm - 8) * 256 * 1024 + pn * 256);
        const int bidx = pm < 8 ? 8 : (pm - 8) >> 3;
        u.o0 = xl; u.o1 = src; u.o2 = (const float*)(X->ws + WS_MODS) + ((size_t)(l * 9 + bidx) * 6 + 2) * 1024 + pn * 256; u.ld = 1024; u.rows = 256; u.flag = (l == 0); u.gidx = nullptr; return true;
    }
};
DI unsigned* panel_cnt(const Ctx& X, int l, int pm) { return (unsigned*)(X.ws + WS_CTL) + CW_PANEL + (l * 72 + pm) * 64; }
DI void merge_publish(const Ctx& X, int l) {
    asm volatile("s_waitcnt vmcnt(0)" ::: "memory");
    __syncthreads();
    if (X.tid == 0) {
        for (int j = 0; j < 2; ++j) { int pm, pn; if (!merge_tile(l, X.G, X.c, j, pm, pn)) break; __hip_atomic_fetch_add(panel_cnt(X, l, pm), 1u, __ATOMIC_RELAXED, __HIP_MEMORY_SCOPE_AGENT); } }
}
DI void out_wait(const Ctx& X, const SchedO& S) {
    if (X.tid == 0) {
        for (int i = 0; i < 2; ++i) { const int pm = S.panel_of(i); if (pm < 0) break; unsigned* f = panel_cnt(X, S.l, pm); unsigned sp = 0;
            while (__hip_atomic_load(f, __ATOMIC_RELAXED, __HIP_MEMORY_SCOPE_AGENT) < 4u) { __builtin_amdgcn_s_sleep(2); if (++sp > (1u << 22)) break; } }
        __builtin_amdgcn_fence(__ATOMIC_ACQUIRE, "agent"); asm volatile("s_waitcnt vmcnt(0)" ::: "memory"); }
    __syncthreads();
}
struct SchedE {
    static constexpr bool PUBLISH = false;
    const Ctx* X; const LAS int* tb; int which, l;
    DI bool next(int i, pg8::Unit& u) const {
        const int ntile = tb[96], nwg = ntile * 4; const int L = i * X->G + X->c; if (L >= nwg) return false;
        const int w = xcd_remap(L, nwg), T = w >> 2, pn = w & 3;
        int e;
        { unsigned am = ~0u; asm volatile("" : "+s"(am)); const int ln = (int)__builtin_amdgcn_mbcnt_hi(am, __builtin_amdgcn_mbcnt_lo(am, 0u));
          const int pv = tb[64 + (ln & 31)]; e = __popcll(__ballot(ln >= 1 && ln < 32 && pv <= T)); }
        const int j = T - tb[64 + e], row0 = tb[e] + 256 * j; int rows = tb[32 + e] - 256 * j; rows = rows > 256 ? 256 : rows;
        u.rows = rows; u.flag = 0; u.gidx = (const int*)(X->ws + WS_ROUTE + RT_SDST) + row0;
        if (which == 1) { u.a = (const char*)(X->ws + WS_H); u.b = (const char*)((const bf16_t*)(X->ws + (l == 0 ? WS_W0GU : WS_WGU)) + ((size_t)e * 1024 + pn * 256) * 1024);
            u.o0 = (bf16_t*)(X->ws + WS_ACT) + (size_t)row0 * 512 + pn * 128; u.o1 = nullptr; u.o2 = nullptr; u.ld = 512; }
        else { u.a = (const char*)((const bf16_t*)(X->ws + WS_ACT) + (size_t)row0 * 512); u.b = (const char*)((const bf16_t*)(X->ws + (l == 0 ? WS_W0D : WS_WD)) + ((size_t)e * 1024 + pn * 256) * 512);
            u.o0 = (bf16_t*)(X->ws + WS_YS) + (size_t)row0 * 1024 + pn * 256; u.o1 = nullptr; u.o2 = (const float*)(X->ws + WS_ROUTE + RT_SW) + row0; u.ld = 1024; }
        return true;
    }
};
template <int W>
struct SchedQ {
    static constexpr bool PUBLISH = (W == 1);
    const Ctx* X; const LAS int* tb; int l, nx, basex; unsigned* cnt;
    DI void init(const Ctx* X_, LAS int* tb_, int l_) {
        X = X_; tb = tb_; l = l_;
        const int nwg = tb[96] * 4, x = X->c & 7, qq = nwg / 8, r = nwg % 8; nx = qq + (x < r ? 1 : 0); basex = (x < r) ? x * (qq + 1) : r * (qq + 1) + (x - r) * qq;
        cnt = (unsigned*)(X->ws + WS_CTL) + CW_GT + l * 192; }
    DI bool next(int i, pg8::Unit& u) const {
        const int rk = X->c >> 3, j = i * 32 + (W == 1 ? rk : 31 - rk); if (j >= nx) return false;
        const int w = basex + j, T = w >> 2, pn = w & 3;
        if (W == 2) {
            if (X->lead()) { const unsigned* f = cnt + T; unsigned sp = 0;
                while (__hip_atomic_load(f, __ATOMIC_RELAXED, __HIP_MEMORY_SCOPE_AGENT) < 4u) { __builtin_amdgcn_s_sleep(2); if (++sp > (1u << 22)) break; }
                __builtin_amdgcn_fence(__ATOMIC_ACQUIRE, "agent"); asm volatile("s_waitcnt vmcnt(0)" ::: "memory"); }
            asm volatile("s_waitcnt lgkmcnt(0)" ::: "memory"); __builtin_amdgcn_s_barrier(); }
        int e;
        { unsigned am = ~0u; asm volatile("" : "+s"(am)); const int ln = (int)__builtin_amdgcn_mbcnt_hi(am, __builtin_amdgcn_mbcnt_lo(am, 0u));
          const int pv = tb[64 + (ln & 31)]; e = __popcll(__ballot(ln >= 1 && ln < 32 && pv <= T)); }
        const int jt = T - tb[64 + e], row0 = tb[e] + 256 * jt; int rows = tb[32 + e] - 256 * jt; rows = rows > 256 ? 256 : rows;
        u.rows = rows; u.flag = T; u.gidx = (const int*)(X->ws + WS_ROUTE + RT_SDST) + row0;
        if (W == 1) { u.a = (const char*)(X->ws + WS_H); u.b = (const char*)((const bf16_t*)(X->ws + (l == 0 ? WS_W0GU : WS_WGU)) + ((size_t)e * 1024 + pn * 256) * 1024);
            u.o0 = (bf16_t*)(X->ws + WS_ACT) + (size_t)row0 * 512 + pn * 128; u.o1 = nullptr; u.o2 = nullptr; u.ld = 512; }
        else { u.a = (const char*)((const bf16_t*)(X->ws + WS_ACT) + (size_t)row0 * 512); u.b = (const char*)((const bf16_t*)(X->ws + (l == 0 ? WS_W0D : WS_WD)) + ((size_t)e * 1024 + pn * 256) * 512);
            u.o0 = (bf16_t*)(X->ws + WS_YS) + (size_t)row0 * 1024 + pn * 256; u.o1 = nullptr; u.o2 = (const float*)(X->ws + WS_ROUTE + RT_SW) + row0; u.ld = 1024; }
        return true;
    }
    DI void done(const pg8::Unit& u) const {
        asm volatile("s_waitcnt vmcnt(0)" ::: "memory"); __builtin_amdgcn_s_barrier();
        if (X->lead()) __hip_atomic_fetch_add(cnt + u.flag, 1u, __ATOMIC_RELAXED, __HIP_MEMORY_SCOPE_AGENT);
    }
};
DI void build_expert_table(const Ctx& X, int l, LAS int* tb) {
    const unsigned* blk = (const unsigned*)(X.ws + WS_CTL) + CW_BLK + l * 8192;
    LAS int* ps = tb + 256;
    { const int e = X.tid & 31, part = X.tid >> 5; int tot = 0, pre = 0;
      int hv[16];
#pragma unroll
      for (int i = 0; i < 16; ++i) hv[i] = (int)blk[(part * 16 + i) * 32 + e];
#pragma unroll
      for (int i = 0; i < 16; ++i) { tot += hv[i]; pre += (part * 16 + i < X.c) ? hv[i] : 0; }
      ps[(part * 2 + 0) * 32 + e] = tot; ps[(part * 2 + 1) * 32 + e] = pre; }
    __syncthreads();
    if (X.tid < 32) { int tot = 0, pre = 0;
        for (int part = 0; part < 16; ++part) { tot += ps[(part * 2 + 0) * 32 + X.tid]; pre += ps[(part * 2 + 1) * 32 + X.tid]; }
        tb[32 + X.tid] = tot; tb[128 + X.tid] = pre; tb[160 + X.tid] = 0; }
    __syncthreads();
    if (X.tid < 32) { int base = 0, tp = 0, tall = 0;
#pragma unroll
        for (int k = 0; k < 32; ++k) { const int c = tb[32 + k], t = (c + 255) >> 8; base += (k < X.tid) ? c : 0; tp += (k < X.tid) ? t : 0; tall += t; }
        tb[X.tid] = base; tb[128 + X.tid] += base; tb[64 + X.tid] = tp; if (X.tid == 0) tb[96] = tall; }
    __syncthreads();
}
#define MFMA32(a, b, c) __builtin_amdgcn_mfma_f32_32x32x16_bf16((a), (b), (c), 0, 0, 0)
DI int crow(int reg, int h) { return (reg & 3) + 8 * (reg >> 2) + 4 * h; }
template <class RowMap>
DI void transpose_item(const float* W, int ldw, int K, bf16_t* WT, int k0, int n0, float scale, const RowMap& rowmap, float* scr, int lane) {
    float tv[32];
#pragma unroll
    for (int i = 0; i < 32; ++i) tv[i] = __builtin_nontemporal_load(W + (size_t)(k0 + 2 * i + (lane >> 5)) * ldw + n0 + (lane & 31));
#pragma unroll
    for (int i = 0; i < 32; ++i) scr[(2 * i + (lane >> 5)) * 33 + (lane & 31)] = tv[i];
    asm volatile("s_waitcnt lgkmcnt(0)" ::: "memory");
    const int c = lane & 7;
#pragma unroll
    for (int j = 0; j < 4; ++j) { const int n = (lane >> 3) + 8 * j; const float* s = scr + (8 * c) * 33 + n;
        u32x4 o; o.x = pk2(s[0 * 33] * scale, s[1 * 33] * scale); o.y = pk2(s[2 * 33] * scale, s[3 * 33] * scale); o.z = pk2(s[4 * 33] * scale, s[5 * 33] * scale); o.w = pk2(s[6 * 33] * scale, s[7 * 33] * scale);
        __builtin_nontemporal_store(o, (u32x4*)(WT + (size_t)rowmap(n0 + n) * K + k0 + 8 * c)); }
    asm volatile("s_waitcnt lgkmcnt(0)" ::: "memory");
}
struct RowId { int off; DI int operator()(int n) const { return n + off; } };
struct RowGU { int gu; DI int operator()(int j) const { return 8 * (j >> 2) + 4 * gu + (j & 3); } };

DI void small_weights(const Ctx& X, char* lds, int l, int c_first, int c_count) {
    if (X.c < c_first || X.c >= c_first + c_count) return;
    const int tid = X.tid, lane = tid & 63, wave = tid >> 6; const int gw = (X.c - c_first) * 8 + wave, NGW = c_count * 8;
    __syncthreads();
    { float* scr = (float*)(lds + wave * 8704);
      constexpr int I_WIN = 16 * (PCOLS / 32), I_WB = 8 * 32, I_WO = 16 * 32, I_L = I_WIN + 3 * I_WB + I_WO;
      for (int it = gw; it < I_L; it += NGW) {
          int r = it;
          if (r < I_WIN) { const int kb = r / (PCOLS / 32), nb = r % (PCOLS / 32), n0 = nb * 32; const int o0 = n0 < PC_GATE ? n0 : n0 + 512;
              const float scale = (n0 < PC_KA || (n0 >= PC_KR && n0 < PC_VR)) ? 0.125f : 1.0f;
              transpose_item(X.in(8) + (size_t)l * 1024 * IN_COLS, IN_COLS, 1024, wsmall(X, l, WO_WIN), kb * 64, o0, scale, RowId{n0 - o0}, scr, lane); continue; }
          r -= I_WIN;
          if (r < 3 * I_WB) { const int br = r / I_WB, q = r % I_WB, kb = q / 32, nb = q % 32;
              const float* pb0 = (X.in(12)); const float* pb1 = (X.in(13)); const float* pb2 = (X.in(14));
              transpose_item((br == 0 ? pb0 : br == 1 ? pb1 : pb2) + (size_t)l * 512 * 1024, 1024, 512, wsmall(X, l, br == 0 ? WO_WBA : br == 1 ? WO_WBF : WO_WBR), kb * 64, nb * 32, 1.0f, RowId{0}, scr, lane); continue; }
          r -= 3 * I_WB;
          { const int kb = r / 32, nb = r % 32; transpose_item(X.in(15) + (size_t)l * 1024 * 1024, 1024, 1024, wsmall(X, l, WO_WOUT), kb * 64, nb * 32, 1.0f, RowId{0}, scr, lane); }
      } }
    __syncthreads();
    { float* t128 = (float*)lds;
      float* wt = (float*)(lds + 1024);
      const int fr_ = lane & 15, fq_ = lane >> 4;
      if (tid < 128) { const float rev = (float)tid * (1.0f / 128.0f); t128[tid] = __builtin_amdgcn_cosf(rev) * 0.08838834764831845f; t128[128 + tid] = __builtin_amdgcn_sinf(rev) * 0.08838834764831845f; }
      for (int it = X.c - c_first; it < 4 * 32; it += c_count) {
          const int g = (it >> 5) & 3, k0 = (it & 31) * 32;
          int fr = fr_, fq = fq_; asm volatile("" : "+v"(fr), "+v"(fq));
          __syncthreads();
          { const float* wsrc = X.in(8) + ((size_t)l * 1024 + k0) * IN_COLS + OC_FU + g * 128;
#pragma unroll
            for (int i = 0; i < 2; ++i) { const int e = tid + 512 * i, kk = e >> 5, c4 = e & 31; *(f32x4*)(wt + kk * 132 + 4 * c4) = *(const f32x4*)(wsrc + (size_t)kk * IN_COLS + 4 * c4); } }
          __syncthreads();
          f32x4 acc[2][2];
#pragma unroll
          for (int rt = 0; rt < 2; ++rt)
#pragma unroll
              for (int ct = 0; ct < 2; ++ct) acc[rt][ct] = (f32x4){0.f, 0.f, 0.f, 0.f};
#pragma unroll
          for (int s = 0; s < 4; ++s) {
              bf16x8 af[2], bfr[2];
#pragma unroll
              for (int rt = 0; rt < 2; ++rt) { const int R = 32 * wave + 16 * rt + fr, cs = R >> 7, j = R & 127; const float* T = t128 + cs * 128; float v[8];
#pragma unroll
                  for (int q = 0; q < 8; ++q) v[q] = T[((32 * s + 8 * fq + q) * j) & 127];
                  u32x4 w; w.x = pk2(v[0], v[1]); w.y = pk2(v[2], v[3]); w.z = pk2(v[4], v[5]); w.w = pk2(v[6], v[7]); af[rt] = __builtin_bit_cast(bf16x8, w); }
#pragma unroll
              for (int ct = 0; ct < 2; ++ct) { const float* wp = wt + (16 * ct + fr) * 132 + 32 * s + 8 * fq; const f32x4 w0 = *(const f32x4*)wp, w1 = *(const f32x4*)(wp + 4);
                  u32x4 w; w.x = pk2(w0[0], w0[1]); w.y = pk2(w0[2], w0[3]); w.z = pk2(w1[0], w1[1]); w.w = pk2(w1[2], w1[3]); bfr[ct] = __builtin_bit_cast(bf16x8, w); }
#pragma unroll
              for (int rt = 0; rt < 2; ++rt)
#pragma unroll
                  for (int ct = 0; ct < 2; ++ct) acc[rt][ct] = __builtin_amdgcn_mfma_f32_16x16x32_bf16(af[rt], bfr[ct], acc[rt][ct], 0, 0, 0);
          }
          bf16_t* WF = wsmall(X, l, WO_WF);
#pragma unroll
          for (int rt = 0; rt < 2; ++rt)
#pragma unroll
              for (int ct = 0; ct < 2; ++ct)
#pragma unroll
                  for (int q = 0; q < 4; ++q) { const int R = 32 * wave + 16 * rt + 4 * fq + q, np = (R >> 7) * 512 + g * 128 + (R & 127); WF[(size_t)np * 1024 + k0 + 16 * ct + fr] = f2bf(acc[rt][ct][q]); }
      }
      __syncthreads(); }
}

DI void phase_prologue(const Ctx& X, char* lds) {
    const int tid = X.tid, lane = tid & 63, wave = tid >> 6;
    const int gw = X.c * 8 + wave, NGW = X.G * 8; const int gt = X.c * 512 + tid, NGT = X.G * 512;
    float* tab = (float*)(X.ws + WS_TAB);
    { float* sv = (float*)lds;
      float* part = (float*)(lds + 36864);
      bool staged = false;
      for (int it = X.c; it < 2 * 96; it += X.G) {
          if (!staged) { for (int e = tid; e < 9 * 1024; e += 512) { const float v = (e < 8192) ? X.in(1)[e] : X.in(3)[e - 8192]; sv[e] = siluf_(v); } staged = true; }
          __syncthreads();
          const int l = it / 96, col = (it % 96) * 64 + lane; const float* W = X.in(6) + (size_t)l * 1024 * 6144;
          float acc[9];
#pragma unroll
          for (int r = 0; r < 9; ++r) acc[r] = 0.f;
#pragma unroll 1
          for (int k0 = wave * 128; k0 < wave * 128 + 128; k0 += 32) { float wv[32];
#pragma unroll
              for (int kk = 0; kk < 32; ++kk) wv[kk] = __builtin_nontemporal_load(W + (size_t)(k0 + kk) * 6144 + col);
#pragma unroll
              for (int kk = 0; kk < 32; ++kk)
#pragma unroll
                  for (int r = 0; r < 9; ++r) acc[r] += sv[r * 1024 + k0 + kk] * wv[kk]; }
#pragma unroll
          for (int r = 0; r < 9; ++r) part[(wave * 9 + r) * 64 + lane] = acc[r];
          __syncthreads();
          for (int e = tid; e < 9 * 64; e += 512) { const int r = e >> 6, cc = e & 63; float s = 0.f;
#pragma unroll
              for (int w8 = 0; w8 < 8; ++w8) s += part[(w8 * 9 + r) * 64 + cc];
              const int cidx = (it % 96) * 64 + cc; __hip_atomic_store((float*)(X.ws + WS_MODS) + ((size_t)(l * 9 + r)) * 6144 + cidx, s + X.in(7)[l * 6144 + cidx], __ATOMIC_RELAXED, __HIP_MEMORY_SCOPE_AGENT); }
          asm volatile("s_waitcnt vmcnt(0)" ::: "memory"); __syncthreads();
          if (tid == 0) __hip_atomic_fetch_add((unsigned*)(X.ws + WS_CTL) + CW_MODS, 1u, __ATOMIC_RELAXED, __HIP_MEMORY_SCOPE_AGENT);
      }
      __syncthreads(); }
    for (int e = gt; e < 512 + 1024 + 65536 + 32; e += NGT) {
        if (e < 512 + 1024 + 65536) {
            int pos, f, nf; float* cdst; float* sdst;
            if (e < 512) { pos = e >> 4; f = e & 15; nf = 16; cdst = tab + TB_ROWC + e; sdst = tab + TB_ROWS + e; }
            else if (e < 1536) { const int q = e - 512; pos = q >> 4; f = q & 15; nf = 16; cdst = tab + TB_COLC + q; sdst = tab + TB_COLS + q; }
            else { const int q = e - 1536; pos = q >> 5; f = q & 31; nf = 32; cdst = tab + TB_RETC + q; sdst = tab + TB_RETS + q; }
            const float inv = exp2f(-(float)f / (float)nf * 13.287712379549449f);
            double s, c; sincos_d((double)((float)pos * inv), s, c); *cdst = (float)c; *sdst = (float)s;
        } else { const int q = e - (512 + 1024 + 65536); const int l = q >> 4, dir = (q >> 3) & 1, hh = q & 7;
            const float* pdf = (X.in(10)); const float* pdb = (X.in(11)); const float xlog = (dir == 0 ? pdf : pdb)[l * 8 + hh];
            const double lg = -log1p(exp(-(double)xlog));
            tab[TB_LG + q] = (float)(lg * 1.4426950408889634); }
    }
    { bf16_t* FN = (bf16_t*)(X.ws + WS_FN); bf16_t* FL = (bf16_t*)(X.ws + WS_FL);
      const int nFN = 2048 * 2048 / 8, nFL = 256 * 512 / 8;
      for (int it = gt; it < nFN + nFL; it += NGT) {
          float v[8]; bf16_t* dst;
          if (it < nFN) { const int k = it >> 8, j0 = (it & 255) * 8; dst = FN + (size_t)k * 2048 + j0; const double sc = 1.0 / sqrt(2048.0), w0 = 6.283185307179586476925 / 2048.0;
#pragma unroll
              for (int j = 0; j < 8; ++j) { const int jj = j0 + j; const bool is_sin = jj > 1024; const int n = is_sin ? jj - 1024 : jj; const int mm = (k * n) & 2047; double s, c; sincos_d(w0 * (double)mm, s, c); v[j] = (float)((is_sin ? -s : c) * sc); } }
          else { const int q = it - nFN, k = q >> 6, n0 = (q & 63) * 8; dst = FL + (size_t)k * 512 + n0; const bool is_sin = n0 >= 256; const int nn0 = is_sin ? n0 - 256 : n0; const double sc = 1.0 / 16.0, w0 = 6.283185307179586476925 / 256.0;
#pragma unroll
              for (int j = 0; j < 8; ++j) { const int mm = (k * (nn0 + j)) & 255; double s, c; sincos_d(w0 * (double)mm, s, c); v[j] = (float)((is_sin ? -s : c) * sc); } }
          u32x4 o; o.x = pk2(v[0], v[1]); o.y = pk2(v[2], v[3]); o.z = pk2(v[4], v[5]); o.w = pk2(v[6], v[7]); *(u32x4*)dst = o; } }
    small_weights(X, lds, 0, 0, X.G);
}

constexpr int N_CONV_ITEMS = 32 * 768;
DI void convert_range(const Ctx& X, int l, char* lds, int item_lo, int item_hi, int c_first, int c_count) {
    if (X.c < c_first || X.c >= c_first + c_count) return;
    const int lane = X.tid & 63, wave = X.tid >> 6; const int gw = (X.c - c_first) * 8 + wave, NGW = c_count * 8;
    float* scr = (float*)(lds + wave * 8704);
    bf16_t* Wgu = (bf16_t*)(X.ws + (l == 0 ? WS_W0GU : WS_WGU)); bf16_t* Wd = (bf16_t*)(X.ws + (l == 0 ? WS_W0D : WS_WD));
    for (int it = item_lo + gw; it < item_hi; it += NGW) {
        int e, r;
        if (l != 0) { e = it / 768; r = it % 768; }
        else if (it < 6144) { e = it / 512; r = it % 512; }
        else if (it < 9216) { const int j = it - 6144; e = j / 256; r = 512 + j % 256; }
        else { const int k = it - 9216; e = 12 + k / 768; r = k % 768; }
        if (r < 512) { const int gu = r >> 8, q = r & 255, kb = q >> 4, nb = q & 15;
            const float* pg0 = (X.in(20)); const float* pg1 = (X.in(21));
            transpose_item((gu == 0 ? pg0 : pg1) + ((size_t)(l * 32 + e)) * 1024 * 512, 512, 1024, Wgu + (size_t)e * 1024 * 1024, kb * 64, nb * 32, 1.0f, RowGU{gu}, scr, lane); }
        else { const int q = r - 512, kb = q >> 5, nb = q & 31;
            transpose_item(X.in(22) + ((size_t)(l * 32 + e)) * 512 * 1024, 1024, 512, Wd + (size_t)e * 1024 * 512, kb * 64, nb * 32, 1.0f, RowId{0}, scr, lane); }
    }
}
constexpr int CV0_P1 = 6144;
constexpr int CV1_A = 7488, CV1_B = 16448;

DI void norm_mod_store(const f32x4 (&v)[4], const float* g, const float* sh, const float* sc, bf16_t* orow, int lane) {
    float ss = 0.f;
#pragma unroll
    for (int j = 0; j < 4; ++j) ss += (v[j].x * v[j].x + v[j].y * v[j].y) + (v[j].z * v[j].z + v[j].w * v[j].w);
    const float rstd = 1.0f / sqrtf(wave_sum(ss, lane) * (1.0f / 1024.0f) + 1e-6f);
#pragma unroll
    for (int j = 0; j < 4; ++j) { const int k = 4 * lane + 256 * j; const f32x4 gg = *(const f32x4*)(g + k), s1 = *(const f32x4*)(sh + k), s2 = *(const f32x4*)(sc + k);
        const f32x4 o = (v[j] * rstd * gg) * (s2 + 1.0f) + s1;
        u32x2 w; w.x = pk2(o.x, o.y); w.y = pk2(o.z, o.w); *(u32x2*)(orow + k) = w; }
}
DI const float* mod_vec(const Ctx& X, int l, int row, int which) { const int bidx = row < R_CTX ? 8 : (row - R_CTX) >> 11; return (const float*)(X.ws + WS_MODS) + ((size_t)(l * 9 + bidx) * 6 + which) * 1024; }

DI void mods_wait(const Ctx& X) {
    if (X.tid == 0) { const unsigned* f = (const unsigned*)(X.ws + WS_CTL) + CW_MODS; unsigned sp = 0;
        while (__hip_atomic_load(f, __ATOMIC_RELAXED, __HIP_MEMORY_SCOPE_AGENT) < 192u) { __builtin_amdgcn_s_sleep(2); if (++sp > (1u << 22)) break; }
        __builtin_amdgcn_fence(__ATOMIC_ACQUIRE, "agent"); asm volatile("s_waitcnt vmcnt(0)" ::: "memory"); }
    __syncthreads();
}
DI void phase_norm0(const Ctx& X) {
    const int lane = X.tid & 63, wave = X.tid >> 6; const int gw = X.c * 8 + wave, NGW = X.G * 8;
    for (int row0 = gw; row0 < R_ALL; row0 += 2 * NGW) {
        f32x4 v[2][4]; int rows[2];
#pragma unroll
        for (int q = 0; q < 2; ++q) { const int row = (row0 + q * NGW < R_ALL) ? row0 + q * NGW : row0; rows[q] = row;
            const float* xr = row < R_CTX ? X.in(2) + (size_t)row * 1024 : X.in(0) + (size_t)(row - R_CTX) * 1024;
#pragma unroll
            for (int j = 0; j < 4; ++j) v[q][j] = *(const f32x4*)(xr + 4 * lane + 256 * j); }
#pragma unroll
        for (int q = 0; q < 2; ++q) if (q == 0 || rows[1] != rows[0]) norm_mod_store(v[q], X.in(4), mod_vec(X, 0, rows[q], 0), mod_vec(X, 0, rows[q], 1), (bf16_t*)(X.ws + WS_H) + (size_t)rows[q] * 1024, lane);
    }
}
DI void phase_combine(const Ctx& X, int l) {
    const int lane = X.tid & 63, wave = X.tid >> 6; const int gw = X.c * 8 + wave, NGW = X.G * 8;
    const bool last = (l == DEPTH - 1); const int row_lo = last ? R_CTX : 0;
    const int* toks = (const int*)(X.ws + WS_ROUTE + RT_TOKE);
    int ns[2][2];
#pragma unroll
    for (int q = 0; q < 2; ++q) { const int r0 = row_lo + gw, row = (r0 + q * NGW < R_ALL) ? r0 + q * NGW : (r0 < R_ALL ? r0 : row_lo); ns[q][0] = toks[row * 2]; ns[q][1] = toks[row * 2 + 1]; }
    for (int row0 = row_lo + gw; row0 < R_ALL; row0 += 2 * NGW) {
        f32x4 v[2][4]; int rows[2];
        u32x2 xq[2][4], ya[2][4], yb[2][4]; f32x4 gg[2][4];
        int cs[2][2];
#pragma unroll
        for (int q = 0; q < 2; ++q) { cs[q][0] = ns[q][0]; cs[q][1] = ns[q][1]; }
        { const int rn = row0 + 2 * NGW;
#pragma unroll
          for (int q = 0; q < 2; ++q) { const int row = (rn + q * NGW < R_ALL) ? rn + q * NGW : (rn < R_ALL ? rn : row0); ns[q][0] = toks[row * 2]; ns[q][1] = toks[row * 2 + 1]; } }
#pragma unroll
        for (int q = 0; q < 2; ++q) { const int row = (row0 + q * NGW < R_ALL) ? row0 + q * NGW : row0; rows[q] = row;
            const bf16_t* xr = (const bf16_t*)(X.ws + WS_XL) + (size_t)row * 1024;
            const bf16_t* y0 = (const bf16_t*)(X.ws + WS_YS) + (size_t)cs[q][0] * 1024; const bf16_t* y1 = (const bf16_t*)(X.ws + WS_YS) + (size_t)cs[q][1] * 1024;
            const float* g2 = mod_vec(X, l, row, 5);
#pragma unroll
            for (int j = 0; j < 4; ++j) { const int k = 4 * lane + 256 * j; xq[q][j] = *(const u32x2*)(xr + k); gg[q][j] = *(const f32x4*)(g2 + k); ya[q][j] = *(const u32x2*)(y0 + k); yb[q][j] = *(const u32x2*)(y1 + k); } }
#pragma unroll
        for (int q = 0; q < 2; ++q)
#pragma unroll
            for (int j = 0; j < 4; ++j) { const u32x2 a = ya[q][j], b = yb[q][j], xx = xq[q][j]; const f32x4 x = (f32x4){bflo(xx.x), bfhi(xx.x), bflo(xx.y), bfhi(xx.y)};
                f32x4 f; f.x = bflo(a.x) + bflo(b.x); f.y = bfhi(a.x) + bfhi(b.x); f.z = bflo(a.y) + bflo(b.y); f.w = bfhi(a.y) + bfhi(b.y);
                v[q][j] = x + gg[q][j] * f; }
#pragma unroll
        for (int q = 0; q < 2; ++q) if (q == 0 || rows[1] != rows[0]) { const int row = rows[q];
            if (!last) { bf16_t* xr = (bf16_t*)(X.ws + WS_XL) + (size_t)row * 1024;
#pragma unroll
                for (int j = 0; j < 4; ++j) { u32x2 w; w.x = pk2(v[q][j].x, v[q][j].y); w.y = pk2(v[q][j].z, v[q][j].w); *(u32x2*)(xr + 4 * lane + 256 * j) = w; }
                norm_mod_store(v[q], X.in(4) + (l + 1) * 1024, mod_vec(X, l + 1, row, 0), mod_vec(X, l + 1, row, 1), (bf16_t*)(X.ws + WS_H) + (size_t)row * 1024, lane);
            } else {
                float ss = 0.f;
#pragma unroll
                for (int j = 0; j < 4; ++j) ss += (v[q][j].x * v[q][j].x + v[q][j].y * v[q][j].y) + (v[q][j].z * v[q][j].z + v[q][j].w * v[q][j].w);
                const float rstd = 1.0f / sqrtf(wave_sum(ss, lane) * (1.0f / 1024.0f) + 1e-6f);
                float* orow = X.out + (size_t)(row - R_CTX) * 1024;
#pragma unroll
                for (int j = 0; j < 4; ++j) { const int k = 4 * lane + 256 * j; const f32x4 g4 = *(const f32x4*)(X.in(23) + k); *(f32x4*)(orow + k) = v[q][j] * rstd * g4; }
            } }
    }
}

DI void router_planes(const Ctx& X) {
    const int gt = X.c * 512 + X.tid, NGT = X.G * 512;
    bf16_t* wrt = (bf16_t*)(X.ws + WS_WRT);
    for (int e = gt; e < 2 * 64 * 1024; e += NGT) { const int l = e >> 16, col = (e >> 10) & 63, k = e & 1023;
        const float w = col < 4 ? X.in(16)[((size_t)l * 1024 + k) * 4 + col] : col < 36 ? X.in(18)[((size_t)l * 1024 + k) * 32 + (col - 4)] : 0.f;
        const bf16_t hi = f2bf(w); const bf16_t lo = f2bf(w - bf2f(hi));
        wrt[((size_t)((l * 2 + 0) * 64 + col)) * 1024 + k] = hi; wrt[((size_t)((l * 2 + 1) * 64 + col)) * 1024 + k] = lo; }
}
DI void phase_route(const Ctx& X, int l, char* lds) {
    const int tid = X.tid, lane = tid & 63, wave = __builtin_amdgcn_readfirstlane(tid >> 6), r = lane & 31, h = lane >> 5;
    constexpr int HP = 1032;
    bf16_t* Hhi = (bf16_t*)lds; bf16_t* Hlo = Hhi + 32 * HP;
    float* P = (float*)lds;
    float* Lg = (float*)(lds + 2 * 32 * HP * 2);
    int* hist = (int*)(lds + 2 * 32 * HP * 2 + 32 * 36 * 4);
    float* Wg = (float*)(lds + 2 * 32 * HP * 2 + 32 * 36 * 4 + 128);
    if (tid < 32) hist[tid] = 0;
    for (int e = tid; e < 4096; e += 512) Wg[(e & 3) * 1024 + (e >> 2)] = X.in(16)[(size_t)l * 4096 + e];
    const int row_lo = (l == DEPTH - 1) ? R_CTX : 0, rpb = (R_ALL - row_lo) / X.G;
    const int rpg = (rpb % 24 == 0) ? 3 : 4, GR = 8 * rpg, ng = rpb / GR;
    int* toke = (int*)(X.ws + WS_ROUTE + RT_TOKE); float* tokw = (float*)(X.ws + WS_ROUTE + RT_TOKW);
    bf16x8 bh[8], bl[8];
    { const bf16_t* wrt = (const bf16_t*)(X.ws + WS_WRT) + (size_t)l * 2 * 64 * 1024 + (size_t)(4 + r) * 1024 + 128 * wave + 8 * h;
#pragma unroll
      for (int s = 0; s < 8; ++s) { bh[s] = *(const bf16x8*)(wrt + 16 * s); bl[s] = *(const bf16x8*)(wrt + 64 * 1024 + 16 * s); } }
    f32x4 gnv[4];
#pragma unroll
    for (int j = 0; j < 4; ++j) gnv[j] = *(const f32x4*)(X.in(5) + l * 1024 + 4 * lane + 256 * j);
    __syncthreads();
#pragma unroll 1
    for (int g = 0; g < ng; ++g) {
        const int rbase = row_lo + X.c * rpb + g * GR;
#pragma unroll 1
        for (int j0 = 0; j0 < rpg; j0 += 2) {
            u32x2 xq[2][4]; f32x4 scv[2][4], shv[2][4]; int rl[2];
#pragma unroll
            for (int q = 0; q < 2; ++q) { const int j = (j0 + q < rpg) ? j0 + q : j0; rl[q] = wave * rpg + j; const int row = rbase + rl[q];
                const bf16_t* xr = (const bf16_t*)(X.ws + WS_XL) + (size_t)row * 1024; const float* sh = mod_vec(X, l, row, 3); const float* sc = mod_vec(X, l, row, 4);
#pragma unroll
                for (int jj = 0; jj < 4; ++jj) { const int k = 4 * lane + 256 * jj; xq[q][jj] = *(const u32x2*)(xr + k); scv[q][jj] = *(const f32x4*)(sc + k); shv[q][jj] = *(const f32x4*)(sh + k); } }
#pragma unroll
            for (int q = 0; q < 2; ++q) if (q == 0 || rl[1] != rl[0]) {
                f32x4 v[4]; float ss = 0.f;
#pragma unroll
                for (int jj = 0; jj < 4; ++jj) { const u32x2 xx = xq[q][jj]; v[jj] = (f32x4){bflo(xx.x), bfhi(xx.x), bflo(xx.y), bfhi(xx.y)}; ss += (v[jj].x * v[jj].x + v[jj].y * v[jj].y) + (v[jj].z * v[jj].z + v[jj].w * v[jj].w); }
                const float rstd = 1.0f / sqrtf(wave_sum(ss, lane) * (1.0f / 1024.0f) + 1e-6f);
                bf16_t* hrow = (bf16_t*)(X.ws + WS_H) + (size_t)(rbase + rl[q]) * 1024;
                float ga[4] = {0.f, 0.f, 0.f, 0.f};
#pragma unroll
                for (int jj = 0; jj < 4; ++jj) { const int k = 4 * lane + 256 * jj; const f32x4 o = (v[jj] * rstd * gnv[jj]) * (scv[q][jj] + 1.0f) + shv[q][jj];
                    u32x2 hi; hi.x = pk2(o.x, o.y); hi.y = pk2(o.z, o.w);
                    u32x2 lo; lo.x = pk2(o.x - bflo(hi.x), o.y - bfhi(hi.x)); lo.y = pk2(o.z - bflo(hi.y), o.w - bfhi(hi.y));
                    *(u32x2*)(hrow + k) = hi; *(u32x2*)(Hhi + rl[q] * HP + k) = hi; *(u32x2*)(Hlo + rl[q] * HP + k) = lo;
#pragma unroll
                    for (int c = 0; c < 4; ++c) { const f32x4 w = *(const f32x4*)(Wg + c * 1024 + k); ga[c] += (o.x * w.x + o.y * w.y) + (o.z * w.z + o.w * w.w); } }
#pragma unroll
                for (int c = 0; c < 4; ++c) ga[c] = wave_sum(ga[c], lane);
                if (lane == 0) {
#pragma unroll
                    for (int c = 0; c < 4; ++c) Lg[rl[q] * 36 + c] = ga[c] + X.in(17)[l * 4 + c]; } }
        }
        __syncthreads();
        f32x16 acc; float zero = 0.f; asm volatile("" : "+v"(zero));
#pragma unroll
        for (int e = 0; e < 16; ++e) acc[e] = zero;
#pragma unroll
        for (int s = 0; s < 8; ++s) { const int kk = 128 * wave + 16 * s + 8 * h;
            const bf16x8 ahi = *(const bf16x8*)(Hhi + r * HP + kk), alo = *(const bf16x8*)(Hlo + r * HP + kk);
            acc = MFMA32(ahi, bh[s], acc); acc = MFMA32(alo, bh[s], acc); acc = MFMA32(ahi, bl[s], acc); }
        __syncthreads();
#pragma unroll
        for (int e = 0; e < 16; ++e) P[(wave * 32 + crow(e, h)) * 32 + r] = acc[e];
        __syncthreads();
        for (int idx = tid; idx < GR * 32; idx += 512) { const int row = idx >> 5, o = idx & 31; float s = 0.f;
#pragma unroll
            for (int w8 = 0; w8 < 8; ++w8) s += P[(w8 * 32 + row) * 32 + o];
            Lg[row * 36 + 4 + o] = s + X.in(19)[l * 32 + o]; }
        __syncthreads();
        if (tid < GR) { const float* lr = Lg + tid * 36; const int row = rbase + tid;
            int grp = 0; float gm = lr[0];
#pragma unroll
            for (int o = 1; o < 4; ++o) if (lr[o] > gm) { gm = lr[o]; grp = o; }
            float den = 0.f;
#pragma unroll
            for (int o = 0; o < 4; ++o) den += __expf(lr[o] - gm);
            const float pg = 1.0f / den; const float* le = lr + 4 + grp * 8;
            int i0 = 0; float v0 = le[0];
#pragma unroll
            for (int j = 1; j < 8; ++j) if (le[j] > v0) { v0 = le[j]; i0 = j; }
            int i1 = -1; float v1 = -3.0e38f;
#pragma unroll
            for (int j = 0; j < 8; ++j) if (j != i0 && le[j] > v1) { v1 = le[j]; i1 = j; }
            const float w0 = pg / (1.0f + __expf(v1 - v0)), w1 = pg - w0; const int e0 = grp * 8 + i0, e1 = grp * 8 + i1;
            toke[row * 2] = e0; toke[row * 2 + 1] = e1; tokw[row * 2] = w0; tokw[row * 2 + 1] = w1;
            atomicAdd(hist + e0, 1); atomicAdd(hist + e1, 1); }
        __syncthreads();
    }
    if (tid < 32) ((unsigned*)(X.ws + WS_CTL) + CW_BLK + l * 8192)[X.c * 32 + tid] = (unsigned)hist[tid];
}
DI void phase_sortcopy(const Ctx& X, int l, char* lds) {
    const int tid = X.tid, lane = tid & 63, wave = tid >> 6;
    LAS int* tb = (LAS int*)(LAS char*)(lds + LDS_TBL);
    build_expert_table(X, l, tb);
    const int* toke = (const int*)(X.ws + WS_ROUTE + RT_TOKE); const float* tokw = (const float*)(X.ws + WS_ROUTE + RT_TOKW);
    int* sdst = (int*)(X.ws + WS_ROUTE + RT_SDST); float* sw = (float*)(X.ws + WS_ROUTE + RT_SW);
    const int row_lo = (l == DEPTH - 1) ? R_CTX : 0, rpb = (R_ALL - row_lo) / X.G, rpw = rpb / 8;
    const int row0 = row_lo + X.c * rpb + wave * rpw;
    int slot = 0;
    if (lane < 2 * rpw) { const int e = toke[row0 * 2 + lane]; const float w = tokw[row0 * 2 + lane];
        slot = tb[128 + e] + __hip_atomic_fetch_add((LAS int*)(tb + 160 + e), 1, __ATOMIC_RELAXED, __HIP_MEMORY_SCOPE_WORKGROUP);
        sdst[slot] = row0 * 2 + lane; sw[slot] = w; ((int*)toke)[row0 * 2 + lane] = slot; }
}
constexpr float L2E = 1.4426950408889634f;
constexpr int KS_LD = 72, VT_LD = 132, ST_LD = 136;
constexpr int LDS_KS = 0, LDS_VT = 128 * KS_LD * 2, LDS_SL = LDS_VT + 64 * 136 * 2;
DI void unpack8(const u32x4 v, float (&f)[8]) { f[0] = bflo(v.x); f[1] = bfhi(v.x); f[2] = bflo(v.y); f[3] = bfhi(v.y); f[4] = bflo(v.z); f[5] = bfhi(v.z); f[6] = bflo(v.w); f[7] = bfhi(v.w); }
DI u32x4 pack8(const float (&f)[8]) { u32x4 o; o.x = pk2(f[0], f[1]); o.y = pk2(f[2], f[3]); o.z = pk2(f[4], f[5]); o.w = pk2(f[6], f[7]); return o; }
DI void rope8(u32x4& a, u32x4& b, const float* tc, const float* ts) {
    float x1[8], x2[8]; unpack8(a, x1); unpack8(b, x2);
    const f32x4 c0 = *(const f32x4*)tc, c1 = *(const f32x4*)(tc + 4), s0 = *(const f32x4*)ts, s1 = *(const f32x4*)(ts + 4);
    float o1[8], o2[8];
#pragma unroll
    for (int j = 0; j < 8; ++j) { const float c = j < 4 ? c0[j & 3] : c1[j & 3], s = j < 4 ? s0[j & 3] : s1[j & 3]; o1[j] = x1[j] * c - x2[j] * s; o2[j] = x1[j] * s + x2[j] * c; }
    a = pack8(o1); b = pack8(o2);
}
template <int LD = VT_LD>
DI void stage_vt(const bf16_t* proj, int row0, int col0, bf16_t* VT, int tid) {
#pragma unroll
    for (int i = 0; i < 2; ++i) { const int p = tid + 512 * i, key = p >> 3, c8 = p & 7;
        const u32x4 v = *(const u32x4*)(PJ(proj, row0 + key, col0 + 8 * c8));
        bf16_t* d = VT + (8 * c8) * LD + key;
        d[0 * LD] = (bf16_t)(v.x & 0xffff); d[1 * LD] = (bf16_t)(v.x >> 16); d[2 * LD] = (bf16_t)(v.y & 0xffff); d[3 * LD] = (bf16_t)(v.y >> 16);
        d[4 * LD] = (bf16_t)(v.z & 0xffff); d[5 * LD] = (bf16_t)(v.z >> 16); d[6 * LD] = (bf16_t)(v.w & 0xffff); d[7 * LD] = (bf16_t)(v.w >> 16); }
}
DI bf16x8 vt_frag(const bf16_t* VT, int dvrow, int kbase, int h) {
    const u32x2 lo = *(const u32x2*)(VT + dvrow * VT_LD + kbase + 4 * h), hi = *(const u32x2*)(VT + dvrow * VT_LD + kbase + 8 + 4 * h);
    u32x4 w; w.x = lo.x; w.y = lo.y; w.z = hi.x; w.w = hi.y; return __builtin_bit_cast(bf16x8, w);
}

constexpr int VR_LD = 96;
typedef short s16x4 __attribute__((ext_vector_type(4)));
DI bf16x8 vr_frag(const bf16_t* vbase, int eoff) {
    typedef __attribute__((address_space(3))) s16x4 lv4;
    const s16x4 lo = __builtin_amdgcn_ds_read_tr16_b64_v4i16((lv4*)(LAS bf16_t*)(vbase + eoff)), hi = __builtin_amdgcn_ds_read_tr16_b64_v4i16((lv4*)(LAS bf16_t*)(vbase + eoff + 8 * VR_LD));
    typedef short s16x8 __attribute__((ext_vector_type(8)));
    const s16x8 w = {lo[0], lo[1], lo[2], lo[3], hi[0], hi[1], hi[2], hi[3]}; return __builtin_bit_cast(bf16x8, w);
}
DI void attn_unit(const Ctx& X, int l, char* lds, bool is_ctx, int b, int kvh, int qblk) {
    const int tid = X.tid, lane = tid & 63, wave = __builtin_amdgcn_readfirstlane(tid >> 6), r = lane & 31, h = lane >> 5;
    const int g = wave >> 1, qh = wave & 1, head = kvh * 4 + g;
    const bf16_t* proj = (const bf16_t*)(X.ws + WS_PROJ); const float* tab = (const float*)(X.ws + WS_TAB);
    bf16_t* Ks = (bf16_t*)(lds + LDS_KS); bf16_t* Vr = (bf16_t*)(lds + LDS_VT);
    const bf16_t* vrb = Vr + (4 * h + ((lane >> 2) & 3)) * VR_LD + 16 * ((lane >> 4) & 1) + 4 * (lane & 3);
    const int qrow0 = is_ctx ? b * 256 + qblk * 128 : R_CTX + b * 2048 + qblk * 128;
    bf16x8 qf[2][4];
#pragma unroll
    for (int qt = 0; qt < 2; ++qt) { const int i = qh * 64 + qt * 32 + r; const bf16_t* qp = PJ(proj, qrow0 + i, PC_QA + head * 64 + 8 * h);
        u32x4 f0 = *(const u32x4*)(qp), f1 = *(const u32x4*)(qp + 16), f2 = *(const u32x4*)(qp + 32), f3 = *(const u32x4*)(qp + 48);
        if (!is_ctx) { const int n = qblk * 128 + i, prow = n >> 6, pcol = n & 63;
            rope8(f0, f1, tab + TB_ROWC + prow * 16 + 8 * h, tab + TB_ROWS + prow * 16 + 8 * h);
            rope8(f2, f3, tab + TB_COLC + pcol * 16 + 8 * h, tab + TB_COLS + pcol * 16 + 8 * h); }
        qf[qt][0] = __builtin_bit_cast(bf16x8, f0); qf[qt][1] = __builtin_bit_cast(bf16x8, f1); qf[qt][2] = __builtin_bit_cast(bf16x8, f2); qf[qt][3] = __builtin_bit_cast(bf16x8, f3); }
    f32x16 O[2][2]; float mrun[2], lsum[2];
#pragma unroll
    for (int qt = 0; qt < 2; ++qt) { mrun[qt] = -1e30f; lsum[qt] = 0.f;
#pragma unroll
        for (int dv = 0; dv < 2; ++dv)
#pragma unroll
            for (int e = 0; e < 16; ++e) O[qt][dv][e] = 0.f; }
    const int nchunk = is_ctx ? 2 : 5;
    u32x4 pka, pkb, pva[2];
    const int skey = tid >> 2, scc = tid & 3, sc = (scc & 1) + 4 * (scc >> 1);
#define ATT_CHUNK(ci_, krow0_, rel_, kblk_, ok_) do { if ((ci_) < 2) { krow0_ = b * 256 + (ci_) * 128; rel_ = 0; kblk_ = 0; ok_ = true; } \
        else { rel_ = (ci_) - 3; kblk_ = qblk + rel_; ok_ = (kblk_ >= 0 && kblk_ < 16); krow0_ = R_CTX + b * 2048 + kblk_ * 128; } } while (0)
#define ATT_ISSUE(ci_) do { int kr_, rl_, kb_; bool ok_; ATT_CHUNK(ci_, kr_, rl_, kb_, ok_); if (ok_) { \
        const bf16_t* kp_ = PJ(proj, kr_ + skey, PC_KA + kvh * 64 + 8 * sc); pka = *(const u32x4*)kp_; pkb = *(const u32x4*)(kp_ + 16); \
        _Pragma("unroll") for (int q_ = 0; q_ < 2; ++q_) { const int p_ = tid + 512 * q_; pva[q_] = *(const u32x4*)(PJ(proj, kr_ + (p_ >> 3), PC_VA + kvh * 64 + 8 * (p_ & 7))); } } } while (0)
    ATT_ISSUE(0);
    for (int ci = 0; ci < nchunk; ++ci) {
        int krow0, rel, kblk; bool okc; ATT_CHUNK(ci, krow0, rel, kblk, okc);
        if (!okc) { continue; }
        __syncthreads();
        { u32x4 a = pka, bq = pkb;
          if (ci >= 2) { const int n = kblk * 128 + skey; const int pos = (sc < 2) ? (n >> 6) : (n & 63);
              rope8(a, bq, tab + ((sc < 2) ? TB_ROWC : TB_COLC) + pos * 16 + 8 * (sc & 1), tab + ((sc < 2) ? TB_ROWS : TB_COLS) + pos * 16 + 8 * (sc & 1)); }
          *(u32x4*)(Ks + skey * KS_LD + 8 * sc) = a; *(u32x4*)(Ks + skey * KS_LD + 8 * sc + 16) = bq;
#pragma unroll
          for (int q = 0; q < 2; ++q) { const int p = tid + 512 * q, key = p >> 3, c8 = p & 7; *(u32x4*)(Vr + key * VR_LD + 8 * c8) = pva[q]; } }
        __syncthreads();
        { int nx = ci + 1; if (nx < nchunk) { int kr2, rl2, kb2; bool ok2; ATT_CHUNK(nx, kr2, rl2, kb2, ok2); if (!ok2) nx = nx + 1; } if (nx < nchunk) { ATT_ISSUE(nx); } }
#pragma unroll 1
        for (int kt = 0; kt < 4; ++kt) {
            if ((rel < 0 && qh == 1 && kt < 2) || (rel > 0 && qh == 0 && kt >= 2)) continue;
            f32x16 st[2];
#pragma unroll
            for (int e = 0; e < 16; ++e) { st[0][e] = 0.f; st[1][e] = 0.f; }
            bf16x8 kf[4];
#pragma unroll
            for (int s = 0; s < 4; ++s) kf[s] = *(const bf16x8*)(Ks + (kt * 32 + r) * KS_LD + 16 * s + 8 * h);
            __builtin_amdgcn_s_setprio(1);
#pragma unroll
            for (int s = 0; s < 4; ++s) { st[0] = MFMA32(kf[s], qf[0][s], st[0]); st[1] = MFMA32(kf[s], qf[1][s], st[1]); }
            __builtin_amdgcn_s_setprio(0);
            bf16x8 vfr[2][2];
#pragma unroll
            for (int dv = 0; dv < 2; ++dv)
#pragma unroll
                for (int s2 = 0; s2 < 2; ++s2) vfr[dv][s2] = vr_frag(vrb, (kt * 32 + 16 * s2) * VR_LD + dv * 32);
            bf16x8 pb[2][2];
#pragma unroll
            for (int qt = 0; qt < 2; ++qt) {
                const int i = qh * 64 + qt * 32 + r;
                if (rel != 0) {
#pragma unroll
                    for (int e = 0; e < 16; ++e) { const int jj = kt * 32 + crow(e, h); const bool ok = (rel < 0) ? (jj >= i) : (jj <= i); st[qt][e] = ok ? st[qt][e] : -1e30f; } }
                float tmax = st[qt][0];
#pragma unroll
                for (int e = 1; e < 16; ++e) tmax = fmaxf(tmax, st[qt][e]);
                tmax = xhalf_max(tmax);
                const float mnew = fmaxf(mrun[qt], tmax), mb = mnew * L2E;
                if (__any(mnew != mrun[qt])) {
                    const float alpha = fast_exp2((mrun[qt] - mnew) * L2E); lsum[qt] *= alpha;
#pragma unroll
                    for (int dv = 0; dv < 2; ++dv)
#pragma unroll
                        for (int e = 0; e < 16; ++e) O[qt][dv][e] *= alpha; }
                mrun[qt] = mnew;
                float ps = 0.f; float p[16];
#pragma unroll
                for (int e = 0; e < 16; ++e) { p[e] = fast_exp2(st[qt][e] * L2E - mb); ps += p[e]; }
                lsum[qt] += ps;
                u32x4 w0, w1; w0.x = pk2(p[0], p[1]); w0.y = pk2(p[2], p[3]); w0.z = pk2(p[4], p[5]); w0.w = pk2(p[6], p[7]); w1.x = pk2(p[8], p[9]); w1.y = pk2(p[10], p[11]); w1.z = pk2(p[12], p[13]); w1.w = pk2(p[14], p[15]);
                pb[qt][0] = __builtin_bit_cast(bf16x8, w0); pb[qt][1] = __builtin_bit_cast(bf16x8, w1);
            }
            __builtin_amdgcn_s_setprio(1);
#pragma unroll
            for (int dv = 0; dv < 2; ++dv)
#pragma unroll
                for (int s2 = 0; s2 < 2; ++s2) { O[0][dv] = MFMA32(vfr[dv][s2], pb[0][s2], O[0][dv]); O[1][dv] = MFMA32(vfr[dv][s2], pb[1][s2], O[1][dv]); }
            __builtin_amdgcn_s_setprio(0);
        }
    }
#undef ATT_CHUNK
#undef ATT_ISSUE
    const float sink = X.in(9)[l * 8 + head];
    bf16_t* oa = (bf16_t*)(X.ws + WS_OA);
#pragma unroll
    for (int qt = 0; qt < 2; ++qt) { float lt = xhalf_sum(lsum[qt]); lt += fast_exp2((sink - mrun[qt]) * L2E); const float inv = 1.0f / lt;
        const int i = qh * 64 + qt * 32 + r; bf16_t* op = oa + (size_t)(qrow0 + i) * 512 + head * 64;
#pragma unroll
        for (int dv = 0; dv < 2; ++dv)
#pragma unroll
            for (int rp = 0; rp < 2; ++rp) { u32x2 w[2];
#pragma unroll
                for (int q = 0; q < 2; ++q) { const int rg = 2 * rp + q; w[q].x = pk2(O[qt][dv][4 * rg] * inv, O[qt][dv][4 * rg + 1] * inv); w[q].y = pk2(O[qt][dv][4 * rg + 2] * inv, O[qt][dv][4 * rg + 3] * inv); }
                const auto s0 = __builtin_amdgcn_permlane32_swap(w[0].x, w[1].x, false, false), s1 = __builtin_amdgcn_permlane32_swap(w[0].y, w[1].y, false, false);
                u32x4 o; o.x = s0[0]; o.y = s1[0]; o.z = s0[1]; o.w = s1[1];
                *(u32x4*)(op + dv * 32 + 8 * (2 * rp + h)) = o; } }
}

DI void fourier_fold_rows(const Ctx& X, char* lds) {
    const int lane = X.tid & 63, wave = X.tid >> 6; const int gw = X.c * 8 + wave, NGW = X.G * 8;
    bf16_t* sr = (bf16_t*)(lds + wave * 8192);
    for (int row = gw; row < 8 * 512; row += NGW) {
        bf16_t* ut = (bf16_t*)(X.ws + WS_UT) + (size_t)row * 4096;
#pragma unroll
        for (int i = 0; i < 8; ++i) *(u32x4*)(sr + (i * 64 + lane) * 8) = *(const u32x4*)(ut + (i * 64 + lane) * 8);
        asm volatile("s_waitcnt vmcnt(0) lgkmcnt(0)" ::: "memory");
#pragma unroll
        for (int i = 0; i < 4; ++i) { const int j0 = (i * 64 + lane) * 8; float v[8];
#pragma unroll
            for (int t = 0; t < 8; ++t) { const int j = j0 + t; float x;
                if (j == 0 || j == 1024) x = bf2f(sr[j]);
                else if (j < 1024) x = bf2f(sr[j]) + bf2f(sr[2048 - j]);
                else { const int n = j - 1024; x = bf2f(sr[2048 + n]) - bf2f(sr[4096 - n]); }
                v[t] = x; }
            *(u32x4*)(ut + j0) = pack8(v); }
        asm volatile("s_waitcnt lgkmcnt(0)" ::: "memory");
    }
}
DI int ret_row0(int b, int c) { return c < 2 ? b * 256 + c * 128 : R_CTX + b * 2048 + (c - 2) * 128; }
DI void stage_ret_k(const Ctx& X, const bf16_t* proj, int b, int hh, int c, bf16_t* Ks, int tid) {
    const float* tab = (const float*)(X.ws + WS_TAB);
    const int pos = tid >> 2, cc = tid & 3; const bf16_t* kp = PJ(proj, ret_row0(b, c) + pos, PC_KR + hh * 64 + 8 * cc);
    u32x4 a = *(const u32x4*)kp, bq = *(const u32x4*)(kp + 32);
    if (c >= 2) { const int n = (c - 2) * 128 + pos; rope8(a, bq, tab + TB_RETC + n * 32 + 8 * cc, tab + TB_RETS + n * 32 + 8 * cc); }
    *(u32x4*)(Ks + pos * KS_LD + 8 * cc) = a; *(u32x4*)(Ks + pos * KS_LD + 32 + 8 * cc) = bq;
}
struct StLoads { u32x4 a, bq, va[2]; f32x4 c0, c1, s0, s1; };
DI void st_issue(const Ctx& X, StLoads& L, int b, int hh, int c) {
    const int tid = X.tid; const bf16_t* proj = (const bf16_t*)(X.ws + WS_PROJ); const float* tab = (const float*)(X.ws + WS_TAB);
    const int pos = tid >> 2, cc = tid & 3, row0 = ret_row0(b, c); const bf16_t* kp = PJ(proj, row0 + pos, PC_KR + hh * 64 + 8 * cc);
    L.a = *(const u32x4*)kp; L.bq = *(const u32x4*)(kp + 32);
    const int n = (c >= 2) ? (c - 2) * 128 + pos : 0; const float* tc = tab + TB_RETC + n * 32 + 8 * cc; const float* ts = tab + TB_RETS + n * 32 + 8 * cc;
    L.c0 = *(const f32x4*)tc; L.c1 = *(const f32x4*)(tc + 4); L.s0 = *(const f32x4*)ts; L.s1 = *(const f32x4*)(ts + 4);
#pragma unroll
    for (int q = 0; q < 2; ++q) { const int p = tid + 512 * q, key = p >> 3, c8 = p & 7; L.va[q] = *(const u32x4*)(PJ(proj, row0 + key, PC_VR + hh * 64 + 8 * c8)); }
}
DI void ret_state_range(const Ctx& X, int l, char* lds, int u0, int ustride, int ulimit) {
    if (u0 >= ulimit) return;
    const int tid = X.tid, lane = tid & 63, wave = __builtin_amdgcn_readfirstlane(tid >> 6), r = lane & 31, h = lane >> 5;
    const float* tab = (const float*)(X.ws + WS_TAB);
    bf16_t* Kf = (bf16_t*)lds; bf16_t* Kb = Kf + 128 * VR_LD; bf16_t* Vr = Kb + 128 * VR_LD;
    const int vro = (4 * h + ((lane >> 2) & 3)) * VR_LD + 16 * ((lane >> 4) & 1) + 4 * (lane & 3);
    StLoads L; st_issue(X, L, u0 / 144, (u0 / 18) & 7, u0 % 18);
#pragma unroll 1
    for (int u = u0; u < ulimit; u += ustride) {
        const int b = u / 144, hh = (u / 18) & 7, c = u % 18;
        const float lgf = tab[TB_LG + l * 16 + hh], lgb = tab[TB_LG + l * 16 + 8 + hh];
        __syncthreads();
        { const int pos = tid >> 2, cc = tid & 3; float k1[8], k2[8]; unpack8(L.a, k1); unpack8(L.bq, k2);
          if (c >= 2) {
#pragma unroll
              for (int j = 0; j < 8; ++j) { const float cv = j < 4 ? L.c0[j & 3] : L.c1[j & 3], sv = j < 4 ? L.s0[j & 3] : L.s1[j & 3]; const float x1 = bf2f(f2bf(k1[j] * cv - k2[j] * sv)), x2 = bf2f(f2bf(k1[j] * sv + k2[j] * cv)); k1[j] = x1; k2[j] = x2; } }
          const float zf = fast_exp2((float)(127 - pos) * lgf), zb = fast_exp2((float)pos * lgb);
          { float a1[8], a2[8], b1[8], b2[8];
#pragma unroll
            for (int j = 0; j < 8; ++j) { a1[j] = k1[j] * zf; a2[j] = k2[j] * zf; b1[j] = k1[j] * zb; b2[j] = k2[j] * zb; }
            *(u32x4*)(Kf + pos * VR_LD + 8 * cc) = pack8(a1); *(u32x4*)(Kf + pos * VR_LD + 32 + 8 * cc) = pack8(a2);
            *(u32x4*)(Kb + pos * VR_LD + 8 * cc) = pack8(b1); *(u32x4*)(Kb + pos * VR_LD + 32 + 8 * cc) = pack8(b2); }
#pragma unroll
          for (int q = 0; q < 2; ++q) { const int p = tid + 512 * q, key = p >> 3, c8 = p & 7; *(u32x4*)(Vr + key * VR_LD + 8 * c8) = L.va[q]; } }
        __syncthreads();
        if (u + ustride < ulimit) { const int u2 = u + ustride; st_issue(X, L, u2 / 144, (u2 / 18) & 7, u2 % 18); }
        const int dir = wave >> 2, dvt = (wave >> 1) & 1, dkt = wave & 1; const bf16_t* kR = (dir ? Kb : Kf) + vro; const bf16_t* vR = Vr + vro;
        f32x16 acc;
#pragma unroll
        for (int e = 0; e < 16; ++e) acc[e] = 0.f;
#pragma unroll
        for (int s = 0; s < 8; ++s) { const bf16x8 a = vr_frag(vR, 16 * s * VR_LD + dvt * 32), bb = vr_frag(kR, 16 * s * VR_LD + dkt * 32); acc = MFMA32(a, bb, acc); }
        float* U = (float*)(X.ws + WS_H) + ((size_t)(((b * 8 + hh) * 18 + c) * 2 + dir)) * 4096;
#pragma unroll
        for (int e = 0; e < 16; ++e) U[(dvt * 32 + crow(e, h)) * 64 + dkt * 32 + r] = acc[e];
    }
}
DI void ret_scan_unit(const Ctx& X, int l, int b, int hh) {
    const int tid = X.tid; const float* tab = (const float*)(X.ws + WS_TAB);
    const float g128f = fast_exp2(128.0f * tab[TB_LG + l * 16 + hh]), g128b = fast_exp2(128.0f * tab[TB_LG + l * 16 + 8 + hh]);
    const float* U = (const float*)(X.ws + WS_H) + (size_t)(b * 8 + hh) * 36 * 4096; bf16_t* S = (bf16_t*)(X.ws + WS_SST) + (size_t)(b * 8 + hh) * 36 * 4096;
    const int e0 = tid * 8;
#define UL(c, dir, j) U[((c) * 2 + (dir)) * 4096 + e0 + (j)]
    const unsigned long long sa = (unsigned long long)S; const unsigned slo = __builtin_amdgcn_readfirstlane((unsigned)sa), shi = __builtin_amdgcn_readfirstlane((unsigned)(sa >> 32));
    const __amdgpu_buffer_rsrc_t srs = __builtin_amdgcn_make_buffer_rsrc((void*)(((unsigned long long)shi << 32) | slo), 0, 36 * 4096 * 2, 0x00020000);
#define SST(c, dir, val) __builtin_amdgcn_raw_buffer_store_b128((val), srs, (unsigned)((((c) * 2 + (dir)) * 4096 + e0) * 2), 0, 16)
    float st[8], z[8];
#pragma unroll
    for (int j = 0; j < 8; ++j) z[j] = 0.f;
#pragma unroll
    for (int j = 0; j < 8; ++j) st[j] = UL(0, 0, j);
    { u32x4 zz = {0u, 0u, 0u, 0u}; asm volatile("" : "+v"(zz)); SST(0, 0, zz); } SST(1, 0, pack8(st));
#pragma unroll
    for (int j = 0; j < 8; ++j) st[j] = g128f * st[j] + UL(1, 0, j);
    for (int c = 2; c < 18; ++c) { SST(c, 0, pack8(st));
#pragma unroll
        for (int j = 0; j < 8; ++j) st[j] = g128f * st[j] + UL(c, 0, j); }
#pragma unroll
    for (int j = 0; j < 8; ++j) st[j] = UL(1, 1, j);
    { u32x4 zz = {0u, 0u, 0u, 0u}; asm volatile("" : "+v"(zz)); SST(1, 1, zz); } SST(0, 1, pack8(st));
#pragma unroll
    for (int j = 0; j < 8; ++j) st[j] = UL(0, 1, j) + g128b * st[j];
    for (int c = 17; c >= 2; --c) { SST(c, 1, pack8(st));
#pragma unroll
        for (int j = 0; j < 8; ++j) st[j] = g128b * st[j] + UL(c, 1, j); }
#undef UL
#undef SST
}
DI unsigned* ret_flag(const Ctx& X, int l, int b, int hh) { return (unsigned*)(X.ws + WS_CTL) + CW_FLAG + ((l * 64 + b * 8 + hh) * 64); }
DI void ret_scan_publish(const Ctx& X, int l, int b, int hh) {
    asm volatile("s_waitcnt vmcnt(0)" ::: "memory");
    __syncthreads();
    if (X.tid == 0) __hip_atomic_store(ret_flag(X, l, b, hh), 1u, __ATOMIC_RELAXED, __HIP_MEMORY_SCOPE_AGENT);
}
DI void ret_scan_wait_all(const Ctx& X, int l) {
    if (X.tid < 64) { unsigned* f = ret_flag(X, l, X.tid >> 3, X.tid & 7); unsigned sp = 0;
        while (__hip_atomic_load(f, __ATOMIC_RELAXED, __HIP_MEMORY_SCOPE_AGENT) == 0u) { __builtin_amdgcn_s_sleep(2); if (++sp > (1u << 22)) break; }
        __builtin_amdgcn_fence(__ATOMIC_ACQUIRE, "agent"); asm volatile("s_waitcnt vmcnt(0)" ::: "memory"); }
    __syncthreads();
}
struct RoLoads { u32x4 ka, kb2, va[2]; f32x4 kc0, kc1, ks0, ks1; u32x4 sst[2]; u32x4 f0, f1, f2, f3; };
DI void ro_issue(const Ctx& X, RoLoads& L, int b, int hh, int c) {
    const int tid = X.tid, lane = tid & 63, wave = tid >> 6, r = lane & 31, h = lane >> 5;
    const bf16_t* proj = (const bf16_t*)(X.ws + WS_PROJ); const float* tab = (const float*)(X.ws + WS_TAB);
    const int row0 = ret_row0(b, c), i = (wave & 3) * 32 + r;
    { const int pos = tid >> 2, cc = tid & 3; const bf16_t* kp = PJ(proj, row0 + pos, PC_KR + hh * 64 + 8 * cc); L.ka = __builtin_nontemporal_load((const u32x4*)kp); L.kb2 = __builtin_nontemporal_load((const u32x4*)(kp + 32));
      const int n = (c >= 2) ? (c - 2) * 128 + pos : 0; const float* tc = tab + TB_RETC + n * 32 + 8 * cc; const float* ts = tab + TB_RETS + n * 32 + 8 * cc;
      L.kc0 = *(const f32x4*)tc; L.kc1 = *(const f32x4*)(tc + 4); L.ks0 = *(const f32x4*)ts; L.ks1 = *(const f32x4*)(ts + 4);
#pragma unroll
      for (int q = 0; q < 2; ++q) { const int p = tid + 512 * q, key = p >> 3, c8 = p & 7; L.va[q] = __builtin_nontemporal_load((const u32x4*)(PJ(proj, row0 + key, PC_VR + hh * 64 + 8 * c8))); } }
    { const bf16_t* S = (const bf16_t*)(X.ws + WS_SST) + ((size_t)((b * 8 + hh) * 18 + c)) * 2 * 4096;
#pragma unroll
      for (int q = 0; q < 2; ++q) L.sst[q] = __builtin_nontemporal_load((const u32x4*)(S + (size_t)(tid + 512 * q) * 8)); }
    { const bf16_t* qp = PJ(proj, row0 + i, PC_QR + hh * 64 + 8 * h);
      L.f0 = __builtin_nontemporal_load((const u32x4*)(qp)); L.f1 = __builtin_nontemporal_load((const u32x4*)(qp + 16)); L.f2 = __builtin_nontemporal_load((const u32x4*)(qp + 32)); L.f3 = __builtin_nontemporal_load((const u32x4*)(qp + 48)); }
}
DI void ret_out_range(const Ctx& X, int l, char* lds, int u0, int ustride, int ucount, int nc, int c0) {
    if (ucount <= 0) return;
    const int tid = X.tid, lane = tid & 63, wave = __builtin_amdgcn_readfirstlane(tid >> 6), r = lane & 31, h = lane >> 5;
    const bf16_t* proj = (const bf16_t*)(X.ws + WS_PROJ); const float* tab = (const float*)(X.ws + WS_TAB);
    bf16_t* Ks = (bf16_t*)(lds + LDS_KS); bf16_t* Vr = (bf16_t*)(lds + LDS_VT); bf16_t* SL = (bf16_t*)(lds + LDS_VT + 128 * VR_LD * 2);
    const bf16_t* vrb = Vr + (4 * h + ((lane >> 2) & 3)) * VR_LD + 16 * ((lane >> 4) & 1) + 4 * (lane & 3);
    const int i = (wave & 3) * 32 + r;
    RoLoads L;
    ro_issue(X, L, (u0 / nc) >> 3, (u0 / nc) & 7, c0 + u0 % nc);
#pragma unroll 1
    for (int k = 0; k < ucount; ++k) {
        const int u = u0 + k * ustride, b = (u / nc) >> 3, hh = (u / nc) & 7, c = c0 + u % nc;
        const float lgf = tab[TB_LG + l * 16 + hh], lgb = tab[TB_LG + l * 16 + 8 + hh];
        const int row0 = ret_row0(b, c);
        u32x2 gg[2][4]; f32x4 qc[4], qs[4];
        { const int n = (c >= 2) ? (c - 2) * 128 + i : 0; const float* tc = tab + TB_RETC + n * 32 + 8 * h; const float* ts = tab + TB_RETS + n * 32 + 8 * h;
          qc[0] = *(const f32x4*)tc; qc[1] = *(const f32x4*)(tc + 4); qc[2] = *(const f32x4*)(tc + 16); qc[3] = *(const f32x4*)(tc + 20);
          qs[0] = *(const f32x4*)ts; qs[1] = *(const f32x4*)(ts + 4); qs[2] = *(const f32x4*)(ts + 16); qs[3] = *(const f32x4*)(ts + 20); }
        if (wave < 4) { const bf16_t* gp = PJ(proj, row0 + i, PC_GR + hh * 64);
#pragma unroll
            for (int dv = 0; dv < 2; ++dv)
#pragma unroll
                for (int rg = 0; rg < 4; ++rg) gg[dv][rg] = *(const u32x2*)(gp + dv * 32 + 8 * rg + 4 * h); }
        __syncthreads();
        { const int pos = tid >> 2, cc = tid & 3; u32x4 ka = L.ka, kb2 = L.kb2;
          if (c >= 2) { float x1[8], x2[8], o1[8], o2[8]; unpack8(ka, x1); unpack8(kb2, x2);
#pragma unroll
              for (int j = 0; j < 8; ++j) { const float cv = j < 4 ? L.kc0[j & 3] : L.kc1[j & 3], sv = j < 4 ? L.ks0[j & 3] : L.ks1[j & 3]; o1[j] = x1[j] * cv - x2[j] * sv; o2[j] = x1[j] * sv + x2[j] * cv; }
              ka = pack8(o1); kb2 = pack8(o2); }
          *(u32x4*)(Ks + pos * KS_LD + 8 * cc) = ka; *(u32x4*)(Ks + pos * KS_LD + 32 + 8 * cc) = kb2;
#pragma unroll
          for (int q = 0; q < 2; ++q) { const int p = tid + 512 * q, key = p >> 3, c8 = p & 7; *(u32x4*)(Vr + key * VR_LD + 8 * c8) = L.va[q]; }
#pragma unroll
          for (int q = 0; q < 2; ++q) { const int e = tid + 512 * q, rowi = e >> 3, ch = e & 7; *(u32x4*)(SL + rowi * KS_LD + 8 * ch) = L.sst[q]; } }
        bf16x8 qf[4];
        { u32x4 f0 = L.f0, f1 = L.f1, f2 = L.f2, f3 = L.f3;
          if (c >= 2) { float x1[8], x2[8], o1[8], o2[8];
              unpack8(f0, x1); unpack8(f2, x2);
#pragma unroll
              for (int j = 0; j < 8; ++j) { const float cv = j < 4 ? qc[0][j & 3] : qc[1][j & 3], sv = j < 4 ? qs[0][j & 3] : qs[1][j & 3]; o1[j] = x1[j] * cv - x2[j] * sv; o2[j] = x1[j] * sv + x2[j] * cv; }
              f0 = pack8(o1); f2 = pack8(o2);
              unpack8(f1, x1); unpack8(f3, x2);
#pragma unroll
              for (int j = 0; j < 8; ++j) { const float cv = j < 4 ? qc[2][j & 3] : qc[3][j & 3], sv = j < 4 ? qs[2][j & 3] : qs[3][j & 3]; o1[j] = x1[j] * cv - x2[j] * sv; o2[j] = x1[j] * sv + x2[j] * cv; }
              f1 = pack8(o1); f3 = pack8(o2); }
          qf[0] = __builtin_bit_cast(bf16x8, f0); qf[1] = __builtin_bit_cast(bf16x8, f1); qf[2] = __builtin_bit_cast(bf16x8, f2); qf[3] = __builtin_bit_cast(bf16x8, f3); }
        __syncthreads();
        if (k + 1 < ucount) { const int u2 = u + ustride; ro_issue(X, L, (u2 / nc) >> 3, (u2 / nc) & 7, c0 + u2 % nc); }
        if (wave < 4) {
            f32x16 O[2];
#pragma unroll
            for (int dv = 0; dv < 2; ++dv)
#pragma unroll
                for (int e = 0; e < 16; ++e) O[dv][e] = 0.f;
#pragma unroll 1
            for (int kt = 0; kt < 4; ++kt) {
                f32x16 st;
#pragma unroll
                for (int e = 0; e < 16; ++e) st[e] = 0.f;
#pragma unroll
                for (int s = 0; s < 4; ++s) st = MFMA32(*(const bf16x8*)(Ks + (kt * 32 + r) * KS_LD + 16 * s + 8 * h), qf[s], st);
                float p[16];
#pragma unroll
                for (int e = 0; e < 16; ++e) { const int d = i - (kt * 32 + crow(e, h)); p[e] = st[e] * (d >= 0 ? fast_exp2((float)d * lgf) : fast_exp2((float)(-d) * lgb)); }
                u32x4 w0, w1; w0.x = pk2(p[0], p[1]); w0.y = pk2(p[2], p[3]); w0.z = pk2(p[4], p[5]); w0.w = pk2(p[6], p[7]); w1.x = pk2(p[8], p[9]); w1.y = pk2(p[10], p[11]); w1.z = pk2(p[12], p[13]); w1.w = pk2(p[14], p[15]);
                const bf16x8 pb0 = __builtin_bit_cast(bf16x8, w0), pb1 = __builtin_bit_cast(bf16x8, w1);
#pragma unroll
                for (int dv = 0; dv < 2; ++dv) { O[dv] = MFMA32(vr_frag(vrb, kt * 32 * VR_LD + dv * 32), pb0, O[dv]); O[dv] = MFMA32(vr_frag(vrb, (kt * 32 + 16) * VR_LD + dv * 32), pb1, O[dv]); }
            }
            const float xif = fast_exp2((float)(i + 1) * lgf), xib = fast_exp2((float)(128 - i) * lgb);
#pragma unroll
            for (int dv = 0; dv < 2; ++dv) { f32x16 cf, cb;
#pragma unroll
                for (int e = 0; e < 16; ++e) { cf[e] = 0.f; cb[e] = 0.f; }
#pragma unroll
                for (int s = 0; s < 4; ++s) { cf = MFMA32(*(const bf16x8*)(SL + (dv * 32 + r) * KS_LD + 16 * s + 8 * h), qf[s], cf); cb = MFMA32(*(const bf16x8*)(SL + (64 + dv * 32 + r) * KS_LD + 16 * s + 8 * h), qf[s], cb); }
#pragma unroll
                for (int e = 0; e < 16; ++e) O[dv][e] += xif * cf[e] + xib * cb[e]; }
            float sm = 0.f;
#pragma unroll
            for (int dv = 0; dv < 2; ++dv)
#pragma unroll
                for (int e = 0; e < 16; ++e) sm += O[dv][e];
            sm = xhalf_sum(sm); const float mu = sm * (1.0f / 64.0f);
            float sq = 0.f;
#pragma unroll
            for (int dv = 0; dv < 2; ++dv)
#pragma unroll
                for (int e = 0; e < 16; ++e) { const float d = O[dv][e] - mu; sq += d * d; }
            sq = xhalf_sum(sq); const float rs = 1.0f / sqrtf(sq * (1.0f / 64.0f) + 1e-5f);
            bf16_t* op = (bf16_t*)(X.ws + WS_RET) + (size_t)(row0 + i) * 512 + hh * 64;
#pragma unroll
            for (int dv = 0; dv < 2; ++dv)
#pragma unroll
                for (int rp = 0; rp < 2; ++rp) { u32x2 w[2];
#pragma unroll
                    for (int q = 0; q < 2; ++q) { const int rg = 2 * rp + q; const u32x2 g2 = gg[dv][rg];
                        const float o0 = siluf_(bflo(g2.x)) * (O[dv][4 * rg] - mu) * rs, o1 = siluf_(bfhi(g2.x)) * (O[dv][4 * rg + 1] - mu) * rs, o2 = siluf_(bflo(g2.y)) * (O[dv][4 * rg + 2] - mu) * rs, o3 = siluf_(bfhi(g2.y)) * (O[dv][4 * rg + 3] - mu) * rs;
                        w[q].x = pk2(o0, o1); w[q].y = pk2(o2, o3); }
                    const auto s0 = __builtin_amdgcn_permlane32_swap(w[0].x, w[1].x, false, false), s1 = __builtin_amdgcn_permlane32_swap(w[0].y, w[1].y, false, false);
                    u32x4 o; o.x = s0[0]; o.y = s1[0]; o.z = s0[1]; o.w = s1[1];
                    *(u32x4*)(op + dv * 32 + 8 * (2 * rp + h)) = o; }
        }
    }
}
#define XB_TMO      128
#define XB_XCNT(j)  (256  + 64 * (j))
#define XB_XSUB(j)  (1280 + 64 * (j))
#define XB_XGEN(j)  (2304 + 64 * (j))
#define XB_TOP      3328
#define XB_TOPGEN   3392
#define XCD_BAR_WORDS 3456
#define XB_SPIN_CAP (1u << 18)
DI unsigned xb_ld(unsigned* p)              { return __hip_atomic_load(p, __ATOMIC_RELAXED, __HIP_MEMORY_SCOPE_AGENT); }
DI unsigned xb_add(unsigned* p, unsigned v) { return __hip_atomic_fetch_add(p, v, __ATOMIC_RELAXED, __HIP_MEMORY_SCOPE_AGENT); }
DI unsigned xb_xcc_id() { return (unsigned)__builtin_amdgcn_s_getreg((3 << 11) | 20) & 0xFu; }
#define XB_SPIN(cond, bar) do { unsigned _sp = 0; while (cond) { __builtin_amdgcn_s_sleep(1); \
    if ((++_sp & 255u) == 0u) { if (xb_ld(&(bar)[XB_TMO])) break; if (_sp > XB_SPIN_CAP) { atomicAdd(&(bar)[XB_TMO], 1u); break; } } } } while (0)
struct XcdBarrier { unsigned* bar; unsigned x; volatile LAS unsigned* st; };
DI XcdBarrier xcd_barrier_post(unsigned* bar, volatile LAS unsigned* st) {
    XcdBarrier b; b.bar = bar; b.x = xb_xcc_id(); b.st = st;
    if (threadIdx.x == 0) (void)xb_add(&bar[XB_XCNT(b.x)], 1u);
    return b;
}
DI void xcd_barrier_complete(unsigned* bar, unsigned x, unsigned& nloc, unsigned& nx) {
    const unsigned G = gridDim.x * gridDim.y * gridDim.z;
    unsigned sum, cnt, mine, sp = 0u;
    for (;;) {
        sum = 0u; cnt = 0u; mine = 0u;
#pragma unroll
        for (unsigned j = 0; j < 16; ++j) { const unsigned c = xb_ld(&bar[XB_XCNT(j)]); sum += c; cnt += (c > 0u) ? 1u : 0u; mine = (j == x) ? c : mine; }
        if (sum == G) break;
        __builtin_amdgcn_s_sleep(1);
        if ((++sp & 255u) == 0u) { if (xb_ld(&bar[XB_TMO])) break; if (sp > XB_SPIN_CAP) { atomicAdd(&bar[XB_TMO], 1u); break; } }
    }
    nloc = mine > 0u ? mine : 1u; nx = cnt > 0u ? cnt : 1u;
}
DI void xcd_barrier(const XcdBarrier& b, const int tid) {
    asm volatile("s_waitcnt vmcnt(0)" ::: "memory");
    __syncthreads();
    if (tid == 0) {
        unsigned* bar = b.bar;
        __builtin_amdgcn_s_waitcnt(0);
        unsigned nloc = b.st[0], nx = b.st[1];
        if (nloc == 0u) { xcd_barrier_complete(bar, b.x, nloc, nx); b.st[0] = nloc; b.st[1] = nx; }
        const unsigned old = xb_add(&bar[XB_XSUB(b.x)], 1u);
        const unsigned gen = old / nloc;
        if (old + 1u == (gen + 1u) * nloc) {
            __builtin_amdgcn_fence(__ATOMIC_RELEASE, "agent");
            asm volatile("s_waitcnt vmcnt(0)" ::: "memory");
            const unsigned og = xb_add(&bar[XB_TOP], 1u);
            const unsigned tg = og / nx;
            if (og + 1u == (tg + 1u) * nx) xb_add(&bar[XB_TOPGEN], 1u);
            else XB_SPIN(xb_ld(&bar[XB_TOPGEN]) == tg, bar);
            __builtin_amdgcn_fence(__ATOMIC_ACQUIRE, "agent");
            xb_add(&bar[XB_XGEN(b.x)], 1u);
            asm volatile("s_waitcnt vmcnt(0)" ::: "memory");
        } else {
            XB_SPIN(xb_ld(&bar[XB_XGEN(b.x)]) == gen, bar);
            __builtin_amdgcn_fence(__ATOMIC_ACQUIRE, "agent");
            asm volatile("s_waitcnt vmcnt(0)" ::: "memory");
        }
    }
    __syncthreads();
}
constexpr int N_PHASES = 20;
#ifndef FUSED_G_L
#define FUSED_G_L 1
#endif

DI void run_phase(const Ctx& X, int ph, unsigned char* lds_raw) {
    char* lds = (char*)lds_raw; LAS unsigned char* ldsL = (LAS unsigned char*)lds_raw;
#ifndef ONLY
#define ONLY -1
#endif
#define EN(k) (ONLY < 0 || ONLY == (k))
    if (ph == 0) { if constexpr (EN(100)) phase_prologue(X, lds); return; }
    if (ph == 1) { if constexpr (EN(101)) { router_planes(X);
#ifndef REP_CONV
#define REP_CONV 1
#endif
        for (int rep = 0; rep < REP_CONV; ++rep) convert_range(X, 0, lds, 0, CV0_P1, 0, X.G);
        mods_wait(X); phase_norm0(X); } return; }
    const int l = (ph - 2) / 9, sub0 = (ph - 2) % 9, sub = sub0 < 3 ? sub0 : (sub0 == 3 ? 4 : sub0 + 2);
    switch (sub) {
    case 0: if constexpr (EN(0)) {
        if (l == 0) { convert_range(X, 1, lds, 0, CV1_A / 2, 152, 104); __syncthreads(); }
#ifdef STAG_A1
        if (l == 1) { const unsigned long long t0 = __builtin_amdgcn_s_memrealtime(); const unsigned long long dl = (unsigned long long)((X.c >> 3) & 3) * STAG_A1;
            while (__builtin_amdgcn_s_memrealtime() - t0 < dl) __builtin_amdgcn_s_sleep(8); }
#endif
        { SchedA S; S.init(&X, l); EpiStore E; pg8::gemm_phase<EpiStore, SchedA, true, true>(ldsL, 1024, S, E, X.tid); }
        if (l == 0) { unsigned char* lr = lds_raw; asm volatile("" : "+s"(lr)); convert_range(X, 1, (char*)lr, CV1_A / 2, CV1_A, 152, 104); }
#ifdef REP_A_NOEPI
        { __syncthreads(); SchedA S; S.init(&X, l); EpiNone E; pg8::gemm_phase<EpiNone, SchedA, true, true>(ldsL, 1024, S, E, X.tid); }
#endif
    } break;
    case 1: if constexpr (EN(1)) { {
#ifndef REP_ATTN
#define REP_ATTN 1
#endif
#ifndef REP_STATE
#define REP_STATE 1
#endif
        fourier_fold_rows(X, lds); __syncthreads();
        if (l == 0) { convert_range(X, 1, lds, CV1_A, (CV1_A + CV1_B) / 2, 0, 112); __syncthreads(); }
        for (int rep = 0; rep < REP_ATTN; ++rep)
        for (int u = X.c; u < 256; u += X.G) attn_unit(X, l, lds, false, u >> 5, (u >> 4) & 1, u & 15);
        if (l == 0) for (int u = X.G - 1 - X.c; u < 32; u += X.G) attn_unit(X, l, lds, true, u >> 2, (u >> 1) & 1, u & 1);
        ret_state_range(X, l, lds, X.c, X.G, 8 * 8 * 18);
        if (l == 0) { __syncthreads(); convert_range(X, 1, lds, (CV1_A + CV1_B) / 2, CV1_B, 112, 112); }
    } } break;
    case 2: if constexpr (EN(2)) { {
        { SchedF2 S; S.X = &X; EpiStore E; pg8::gemm_phase<EpiStore, SchedF2, false, true>(ldsL, 2048, S, E, X.tid, 2048, 4096); }
        if (l == 0) { SchedF2c S; S.X = &X; EpiStore E; pg8::gemm_phase<EpiStore, SchedF2c, false, true>(ldsL, 512, S, E, X.tid); }
        if (X.c >= 192) { const int u = X.c - 192; ret_scan_unit(X, l, u >> 3, u & 7); ret_scan_publish(X, l, u >> 3, u & 7); }
        { const int nc = (l == 0) ? 18 : 16, c0 = (l == 0) ? 0 : 2, NU = 64 * nc;
          ret_scan_wait_all(X, l);
#ifndef REP_RETOUT
#define REP_RETOUT 1
#endif
          if (X.c >= 128) ret_out_range(X, l, lds, X.c - 128, 128, 6, nc, c0);
          else ret_out_range(X, l, lds, 768 + X.c, 128, (NU - 768 - X.c + 127) / 128, nc, c0); }
    } } break;
    case 4: if constexpr (EN(4)) { { SchedM S; S.init(&X, l); EpiMerge E; pg8::gemm_phase<EpiMerge, SchedM, true, true>(ldsL, 512, S, E, X.tid); }
        merge_publish(X, l);
        { SchedO S; S.init(&X, l); out_wait(X, S); EpiOut E; pg8::gemm_phase<EpiOut, SchedO, true, true>(ldsL, 1024, S, E, X.tid); }
#ifdef PROBE_NOCONV
        if (l == 0 && X.out != nullptr) convert_range(X, 0, lds, CV0_P1, N_CONV_ITEMS, 96, 160); } break;
#else
        if (l == 0) convert_range(X, 0, lds, CV0_P1, N_CONV_ITEMS, 96, 160); } break;
#endif
#ifndef REP_ROUTE
#define REP_ROUTE 1
#endif
    case 6: if constexpr (EN(6)) { for (int rep = 0; rep < REP_ROUTE; ++rep) { phase_route(X, l, lds); if (REP_ROUTE > 1) __syncthreads(); } } break;
    case 7: if constexpr (EN(7)) { phase_sortcopy(X, l, lds); } break;
    case 8: if constexpr (EN(8)) { if (l == FUSED_G_L) {
            LAS int* tb = (LAS int*)(ldsL + LDS_TBL); build_expert_table(X, l, tb);
            { SchedQ<1> S; S.init(&X, tb, l); EpiGU_<true> E; pg8::gemm_phase<EpiGU_<true>, SchedQ<1>, true, true, true>(ldsL, 1024, S, E, X.tid); }
            { const int t2 = X.fresh_tid();
              SchedQ<2> S; S.init(&X, tb, l); EpiDown E; pg8::gemm_phase<EpiDown, SchedQ<2>, true, true>(ldsL, 512, S, E, t2); }
        } else { LAS int* tb = (LAS int*)(ldsL + LDS_TBL); build_expert_table(X, l, tb); SchedE S; S.X = &X; S.tb = tb; S.which = 1; S.l = l; EpiGU E;
        const int rem1 = (l == 0) ? (tb[96] * 4) % X.G : 0; constexpr int CVH = (CV1_B + N_CONV_ITEMS) / 2;
        if (rem1 != 0) { convert_range(X, 1, lds, CV1_B, CVH, rem1, X.G - rem1); __syncthreads(); }
        pg8::gemm_phase<EpiGU, SchedE, true, true, true>(ldsL, 1024, S, E, X.tid);
        if (rem1 != 0) { unsigned char* lr = lds_raw; asm volatile("" : "+s"(lr)); __syncthreads(); Ctx Y = X; Y.tid = X.fresh_tid(); convert_range(Y, 1, (char*)lr, CVH, N_CONV_ITEMS, rem1, X.G - rem1); } } } break;
    case 9: if constexpr (EN(9)) { if (l != FUSED_G_L) { LAS int* tb = (LAS int*)(ldsL + LDS_TBL); build_expert_table(X, l, tb); SchedE S; S.X = &X; S.tb = tb; S.which = 2; S.l = l; EpiDown E;
#ifndef REP_G2
#define REP_G2 1
#define REP_G2_L 1
#endif
        for (int rep = 0; rep < ((l == REP_G2_L) ? REP_G2 : 1); ++rep) pg8::gemm_phase<EpiDown, SchedE, true, true>(ldsL, 512, S, E, X.tid);
        if (l == 0) { const int rem = (tb[96] * 4) % X.G; if (rem != 0) { unsigned char* lr = lds_raw; asm volatile("" : "+s"(lr)); Ctx Y = X; Y.tid = X.fresh_tid(); small_weights(Y, (char*)lr, 1, rem, X.G - rem); } } } } break;
    case 10: if constexpr (EN(10)) { { phase_combine(X, l); if (l == 0) { LAS int* tb = (LAS int*)(ldsL + LDS_TBL); build_expert_table(X, 0, tb); if ((tb[96] * 4) % X.G == 0) { convert_range(X, 1, lds, CV1_B, N_CONV_ITEMS, 0, X.G); small_weights(X, lds, 1, 0, X.G); } } } } break;
    }
}

__global__ void __launch_bounds__(512, 2) fwd_kernel(Params p) {
    extern __shared__ __attribute__((aligned(16))) unsigned char lds_raw[];
    const int wave_s = __builtin_amdgcn_readfirstlane((int)threadIdx.x >> 6);
    volatile LAS unsigned* bst = (volatile LAS unsigned*)((LAS unsigned char*)lds_raw + LDS_BYTES - 64);
    if (threadIdx.x < 2) bst[threadIdx.x] = 0u;
    __syncthreads();
    if (p.ph_hi < 0) cg::this_grid().sync();
    XcdBarrier xbar; xbar.bar = nullptr; xbar.x = 0; xbar.st = bst;
    if (p.ph_hi - p.ph_lo > 1) xbar = xcd_barrier_post((unsigned*)(p.ws + WS_CTL) + CW_BAR, bst);
#define SEAM(k) do { { unsigned am2_ = ~0u; asm volatile("" : "+s"(am2_)); const int t2_ = wave_s * 64 + (int)__builtin_amdgcn_mbcnt_hi(am2_, __builtin_amdgcn_mbcnt_lo(am2_, 0u)); xcd_barrier(xbar, t2_); } } while (0)
#define MAKE_CTX(X) Ctx X; { unsigned am_ = ~0u; asm volatile("" : "+s"(am_)); int t = wave_s * 64 + (int)__builtin_amdgcn_mbcnt_hi(am_, __builtin_amdgcn_mbcnt_lo(am_, 0u)), c = blockIdx.x; KParams kp = (KParams)__builtin_amdgcn_kernarg_segment_ptr(); asm volatile("" : "+v"(t), "+s"(c), "+s"(kp)); X.tid = t; X.c = c; X.P = kp; } X.out = X.P->out; X.ws = X.P->ws; X.G = gridDim.x; X.wv = wave_s;
    if (p.ph_lo <= 0 && 0 < p.ph_hi) { MAKE_CTX(X); run_phase(X, 0, lds_raw); }
    if (p.ph_lo <= 1 && 1 < p.ph_hi) { MAKE_CTX(X); run_phase(X, 1, lds_raw); if (2 < p.ph_hi) SEAM(1); }
    for (int ph = p.ph_lo < 2 ? 2 : p.ph_lo; ph < p.ph_hi; ++ph) {
        MAKE_CTX(X);
        run_phase(X, ph, lds_raw);
        if (ph + 1 < p.ph_hi && ph != 2 + 9 * FUSED_G_L + 6) SEAM(ph);
    }
}

extern "C" void kernel_launch(void* const* d_in, const int* in_sizes, int n_in, void* d_out, int out_size, void* d_ws, size_t ws_size, hipStream_t stream) {
    static int grid = 0;
    if (grid == 0) {
        if (n_in != 24 || out_size != R_LAT * D || ws_size < WS_END2) { fprintf(stderr, "kernel_launch: unexpected problem (n_in %d, out %d, ws %zu < %zu)\n", n_in, out_size, ws_size, (size_t)WS_END2); grid = -1; return; }
        if (hipFuncSetAttribute((const void*)fwd_kernel, hipFuncAttributeMaxDynamicSharedMemorySize, LDS_BYTES) != hipSuccess) { fprintf(stderr, "kernel_launch: hipFuncSetAttribute failed\n"); grid = -1; return; }
        int dev = 0, cus = 0, per_cu = 0; hipGetDevice(&dev); hipDeviceGetAttribute(&cus, hipDeviceAttributeMultiprocessorCount, dev);
        hipOccupancyMaxActiveBlocksPerMultiprocessor(&per_cu, (const void*)fwd_kernel, 512, LDS_BYTES);
        (void)hipGetLastError();
        if (cus != 256 || per_cu < 1) { fprintf(stderr, "kernel_launch: needs 256 CUs with one resident workgroup each (cus %d, per_cu %d)\n", cus, per_cu); }
        grid = 256;
    }
    if (grid < 0) return;
    hipMemsetAsync((char*)d_ws + WS_CTL, 0, CTL_BYTES, stream);
    Params p{};
    for (int i = 0; i < 24; ++i) p.in[i] = (const float*)d_in[i];
    p.out = (float*)d_out; p.ws = (unsigned char*)d_ws;
#if MK_LAUNCHES == 1
    p.ph_lo = 0; p.ph_hi = N_PHASES;
    void* args[] = {&p};
    hipError_t e = hipLaunchCooperativeKernel((const void*)fwd_kernel, dim3(grid), dim3(512), args, LDS_BYTES, stream);
    if (e != hipSuccess) fprintf(stderr, "cooperative launch failed: %s\n", hipGetErrorString(e));
#else
    for (int ph = 0; ph < N_PHASES; ++ph) { p.ph_lo = ph; p.ph_hi = ph + 1; hipLaunchKernelGGL(fwd_kernel, dim3(grid), dim3(512), LDS_BYTES, stream, p);
#ifdef PROBE_REPEAT
        if (ph == PROBE_REPEAT) { Params p2 = p;
#ifdef PROBE_NOCONV
            p2.out = nullptr;
#endif
            for (int rr = 0; rr < PROBE_TIMES; ++rr) hipLaunchKernelGGL(fwd_kernel, dim3(grid), dim3(512), LDS_BYTES, stream, p2); }
#endif
    }
#endif
}
```
